# Optimizing an MI355X kernel written in HIP

```python
import jax, jax.numpy as jnp
from jax import lax
import numpy as np

D_MODEL = 2048
BATCH = 4
SEQ = 4096
DEPTH = 1
DEC_BATCH = 32
DEC_SEQ = 8
PAST_LEN = 16384
PAGE_SIZE = 128

A_WINDOWS = (128, 512, 2048)
A_DILATIONS = (1, 4, 16)
A_GROUPS = 3
A_HEADS = 8
A_HEAD_DIM = 128
A_WIDTH = A_HEADS * A_HEAD_DIM
A_QBLOCK = 128
ATT_SCALE = A_HEAD_DIM ** -0.5
SSM_D_INNER = D_MODEL
SSM_HEAD_DIM = 64
SSM_HEADS = SSM_D_INNER // SSM_HEAD_DIM
SSM_GROUPS = 8
SSM_D_STATE = 128
SSM_CONV_W = 4
SSM_CHUNK = 128
SSM_CONV_DIM = SSM_D_INNER + 2 * SSM_GROUPS * SSM_D_STATE
QKV_WIDTH = A_GROUPS * A_WIDTH
IN_SPLITS = (QKV_WIDTH, QKV_WIDTH, QKV_WIDTH, A_WIDTH, SSM_D_INNER, SSM_CONV_DIM, SSM_HEADS, D_MODEL, D_MODEL)
IN_WIDTH = sum(IN_SPLITS)
NORM_EPS = 1e-6

kernel_name = "hybrid_dilated_attn_ssd_step"


def _rmsnorm(x, g):
    xf = x.astype(jnp.float32)
    y = xf * lax.rsqrt(jnp.mean(xf * xf, axis=-1, keepdims=True) + NORM_EPS)
    return (y * g.astype(jnp.float32)).astype(x.dtype)


def _masked_softmax_lse(scores, mask):
    s = jnp.where(mask, scores, -jnp.inf)
    m = jnp.max(s, axis=-1, keepdims=True)
    e = jnp.exp(s - m)
    z = jnp.sum(e, axis=-1, keepdims=True)
    return e / z, (m + jnp.log(z))[..., 0]


def _dilated_attn_prompt(q, k, v, window, dilation):
    bsz, s, h, e = q.shape
    nk = window // dilation
    L = s // dilation
    qb = A_QBLOCK
    nb = -(-L // qb)
    lp = nb * qb

    def to_sub(t):
        return t.reshape(bsz, L, dilation, h, e).transpose(0, 2, 1, 3, 4)

    qs = jnp.pad(to_sub(q), ((0, 0), (0, 0), (0, lp - L), (0, 0), (0, 0))).reshape(bsz, dilation, nb, qb, h, e)
    kpad = ((0, 0), (0, 0), (nk, lp - L), (0, 0), (0, 0))
    ks = jnp.pad(to_sub(k), kpad)
    vs = jnp.pad(to_sub(v), kpad)
    kj = jnp.arange(qb + nk)
    idx = jnp.arange(nb)[:, None] * qb + kj[None, :]
    kb = ks[:, :, idx]
    vb = vs[:, :, idx]
    scores = jnp.einsum('bdnqhe,bdnkhe->bdnhqk', qs, kb, preferred_element_type=jnp.float32) * ATT_SCALE
    dist = jnp.arange(qb)[:, None] + nk - kj[None, :]
    key_sub = idx[:, None, :] - nk
    mask = (dist >= 0) & (dist <= nk) & (key_sub >= 0)
    p, lse = _masked_softmax_lse(scores, mask[None, None, :, None])
    o = jnp.einsum('bdnhqk,bdnkhe->bdnqhe', p.astype(vb.dtype), vb, preferred_element_type=jnp.float32)
    o = o.reshape(bsz, dilation, lp, h, e)[:, :, :L].transpose(0, 2, 1, 3, 4).reshape(bsz, s, h, e)
    lse = lse.transpose(0, 1, 2, 4, 3).reshape(bsz, dilation, lp, h)[:, :, :L]
    lse = lse.transpose(0, 2, 1, 3).reshape(bsz, s, h)
    return o, lse


def _dilated_attn_decode(q, k_new, v_new, kv_buf, window, dilation):
    wb = kv_buf.shape[1]
    t = q.shape[1]
    nk = window // dilation
    k_ctx = jnp.concatenate([kv_buf[:, :, 0], k_new], axis=1)
    v_ctx = jnp.concatenate([kv_buf[:, :, 1], v_new], axis=1)
    idx = wb + jnp.arange(t)[:, None] - jnp.arange(nk + 1)[None, :] * dilation
    valid = idx >= 0
    idxc = jnp.maximum(idx, 0)
    kg = k_ctx[:, idxc]
    vg = v_ctx[:, idxc]
    scores = jnp.einsum('bthe,btkhe->bthk', q, kg, preferred_element_type=jnp.float32) * ATT_SCALE
    p, lse = _masked_softmax_lse(scores, valid[None, :, None, :])
    o = jnp.einsum('bthk,btkhe->bthe', p.astype(vg.dtype), vg, preferred_element_type=jnp.float32)
    new_buf = jnp.concatenate([kv_buf, jnp.stack([k_new, v_new], axis=2)], axis=1)[:, t:]
    return o, lse, new_buf


def _ssd(xs, dt, a, bm, cm, h0):
    f32 = jnp.float32
    bsz, l, nh, p = xs.shape
    g, n = bm.shape[2], bm.shape[3]
    r = nh // g
    chunk = SSM_CHUNK if l % SSM_CHUNK == 0 else l
    nc = l // chunk
    xdt = (xs.astype(f32) * dt[..., None]).reshape(bsz, nc, chunk, g, r, p)
    bc = bm.astype(f32).reshape(bsz, nc, chunk, g, n)
    cc = cm.astype(f32).reshape(bsz, nc, chunk, g, n)
    da = (dt * a).reshape(bsz, nc, chunk, g, r).transpose(0, 3, 4, 1, 2)
    cs = jnp.cumsum(da, axis=-1)
    tri = jnp.tril(jnp.ones((chunk, chunk), dtype=bool))
    decay = jnp.exp(jnp.where(tri, cs[..., :, None] - cs[..., None, :], -jnp.inf))
    cb = jnp.einsum('bclgn,bcsgn->bgcls', cc, bc)
    y_diag = jnp.einsum('bgcls,bgrcls,bcsgrp->bclgrp', cb, decay, xdt)
    decay_states = jnp.exp(cs[..., -1:] - cs)
    states = jnp.einsum('bcsgn,bgrcs,bcsgrp->bcgrpn', bc, decay_states, xdt)
    states = jnp.concatenate([h0.astype(f32).reshape(bsz, 1, g, r, p, n), states], axis=1)
    cz = jnp.cumsum(jnp.pad(cs[..., -1], ((0, 0), (0, 0), (0, 0), (1, 0))), axis=-1)
    tri_c = jnp.tril(jnp.ones((nc + 1, nc + 1), dtype=bool))
    decay_chunk = jnp.exp(jnp.where(tri_c, cz[..., :, None] - cz[..., None, :], -jnp.inf))
    new_states = jnp.einsum('bgrzc,bcgrpn->bzgrpn', decay_chunk, states)
    y_off = jnp.einsum('bclgn,bcgrpn,bgrcl->bclgrp', cc, new_states[:, :-1], jnp.exp(cs))
    y = (y_diag + y_off).reshape(bsz, l, nh, p)
    final = new_states[:, -1].reshape(bsz, nh, p, n).astype(h0.dtype)
    return y, final


def _layer(x, c, kv_bufs, conv_state, ssm_state, decode,
           w_ada, b_ada, g_pre, g_post, w_in, conv_w, conv_b, dt_bias, a_log, d_skip, g_ssm, w_o_a, w_o_b, w_o):
    bsz, l, _ = x.shape
    mod = jax.nn.silu(c) @ w_ada + b_ada
    shift, scale, gate = jnp.split(mod, 3, axis=-1)
    h = _rmsnorm(x, g_pre) * (1 + scale[:, None]) + shift[:, None]
    proj = h @ w_in
    cuts = [int(i) for i in np.cumsum(IN_SPLITS)[:-1]]
    q, k, v, z_a, z_b, xbc, dt_raw, r_a, r_b = jnp.split(proj, cuts, axis=-1)

    q = q.reshape(bsz, l, A_GROUPS, A_HEADS, A_HEAD_DIM)
    k = k.reshape(bsz, l, A_GROUPS, A_HEADS, A_HEAD_DIM)
    v = v.reshape(bsz, l, A_GROUPS, A_HEADS, A_HEAD_DIM)
    outs, lses, new_bufs = [], [], []
    for gi in range(A_GROUPS):
        w, d = A_WINDOWS[gi], A_DILATIONS[gi]
        qg, kg, vg = q[:, :, gi], k[:, :, gi], v[:, :, gi]
        if decode:
            o, lse, nbuf = _dilated_attn_decode(qg, kg, vg, kv_bufs[gi], w, d)
        else:
            o, lse = _dilated_attn_prompt(qg, kg, vg, w, d)
            nbuf = jnp.stack([kg, vg], axis=2)[:, -min(w, l):]
        outs.append(o)
        lses.append(lse)
        new_bufs.append(nbuf)
    wts = jax.nn.softmax(jnp.stack(lses, axis=0), axis=0)
    o_a = jnp.sum(wts[..., None] * jnp.stack(outs, axis=0), axis=0)
    o_a = o_a.reshape(bsz, l, A_WIDTH).astype(x.dtype) * jax.nn.silu(z_a)
    p_a = o_a @ w_o_a

    ext = jnp.concatenate([conv_state, xbc], axis=1)
    conv = conv_b
    for kk in range(SSM_CONV_W):
        conv = conv + conv_w[kk] * ext[:, kk:kk + l]
    new_conv = ext[:, l:]
    xbc_act = jax.nn.silu(conv)
    xs, bm, cm = jnp.split(xbc_act, [SSM_D_INNER, SSM_D_INNER + SSM_GROUPS * SSM_D_STATE], axis=-1)
    xs = xs.reshape(bsz, l, SSM_HEADS, SSM_HEAD_DIM)
    bm = bm.reshape(bsz, l, SSM_GROUPS, SSM_D_STATE)
    cm = cm.reshape(bsz, l, SSM_GROUPS, SSM_D_STATE)
    dt = jax.nn.softplus(dt_raw.astype(jnp.float32) + dt_bias.astype(jnp.float32))
    a = -jnp.exp(a_log.astype(jnp.float32))
    y, new_ssm = _ssd(xs, dt, a, bm, cm, ssm_state)
    y = y + xs.astype(jnp.float32) * d_skip.astype(jnp.float32)[:, None]
    yg = y.reshape(bsz, l, SSM_D_INNER) * jax.nn.silu(z_b.astype(jnp.float32))
    yg = yg.reshape(bsz, l, SSM_GROUPS, SSM_D_INNER // SSM_GROUPS)
    yg = yg * lax.rsqrt(jnp.mean(yg * yg, axis=-1, keepdims=True) + NORM_EPS)
    yn = (yg.reshape(bsz, l, SSM_D_INNER) * g_ssm.astype(jnp.float32)).astype(x.dtype)
    p_b = yn @ w_o_b

    merged = jax.nn.sigmoid(r_a) * p_a + jax.nn.sigmoid(r_b) * p_b
    out = merged @ w_o
    y_out = x + gate[:, None] * _rmsnorm(out, g_post)
    return y_out, new_bufs, new_conv, new_ssm


def setup_inputs(seed: int = 0) -> dict:
    key = jax.random.key(seed)
    ks = jax.random.split(key, 24)
    f32 = jnp.float32

    def nrm(k, shape, s):
        return jax.random.normal(k, shape, f32) * s

    wb = [min(w, PAST_LEN) for w in A_WINDOWS]
    kv_shape = lambda n: (DEPTH, DEC_BATCH, n, 2, A_HEADS, A_HEAD_DIM)
    dt0 = jnp.exp(jax.random.uniform(ks[15], (DEPTH, SSM_HEADS), f32, np.log(1e-3), np.log(1e-1)))
    return {
        "x_prompt": nrm(ks[0], (BATCH, SEQ, D_MODEL), 1.0),
        "x_sample": nrm(ks[1], (DEC_BATCH, DEC_SEQ, D_MODEL), 1.0),
        "cache_a_w128": nrm(ks[2], kv_shape(wb[0]), 1.0),
        "cache_a_w512": nrm(ks[3], kv_shape(wb[1]), 1.0),
        "cache_a_w2048": nrm(ks[4], kv_shape(wb[2]), 1.0),
        "state_conv": nrm(ks[5], (DEPTH, DEC_BATCH, SSM_CONV_W - 1, SSM_CONV_DIM), 1.0),
        "state_ssm": nrm(ks[6], (DEPTH, DEC_BATCH, SSM_HEADS, SSM_HEAD_DIM, SSM_D_STATE), 0.1),
        "c_prompt": nrm(ks[7], (BATCH, D_MODEL), 1.0),
        "c_sample": nrm(ks[8], (DEC_BATCH, D_MODEL), 1.0),
        "w_ada": nrm(ks[9], (DEPTH, D_MODEL, 3 * D_MODEL), 0.2 * D_MODEL ** -0.5),
        "b_ada": nrm(ks[10], (DEPTH, 3 * D_MODEL), 0.01),
        "g_pre": 1.0 + nrm(ks[11], (DEPTH, D_MODEL), 0.05),
        "g_post": 1.0 + nrm(ks[12], (DEPTH, D_MODEL), 0.05),
        "w_in": nrm(ks[13], (DEPTH, D_MODEL, IN_WIDTH), D_MODEL ** -0.5),
        "conv_w": nrm(ks[14], (DEPTH, SSM_CONV_W, SSM_CONV_DIM), SSM_CONV_W ** -0.5),
        "conv_b": nrm(ks[16], (DEPTH, SSM_CONV_DIM), 0.01),
        "dt_bias": dt0 + jnp.log(-jnp.expm1(-dt0)),
        "a_log": jnp.log(jax.random.uniform(ks[17], (DEPTH, SSM_HEADS), f32, 1.0, 16.0)),
        "d_skip": 1.0 + nrm(ks[18], (DEPTH, SSM_HEADS), 0.05),
        "g_ssm": 1.0 + nrm(ks[19], (DEPTH, SSM_D_INNER), 0.05),
        "w_o_a": nrm(ks[20], (DEPTH, A_WIDTH, D_MODEL), A_WIDTH ** -0.5),
        "w_o_b": nrm(ks[21], (DEPTH, SSM_D_INNER, D_MODEL), SSM_D_INNER ** -0.5),
        "w_o": nrm(ks[22], (DEPTH, D_MODEL, D_MODEL), D_MODEL ** -0.5),
    }


def reference(x_prompt, x_sample, cache_a_w128, cache_a_w512, cache_a_w2048, state_conv, state_ssm,
              c_prompt, c_sample, w_ada, b_ada, g_pre, g_post, w_in, conv_w, conv_b, dt_bias, a_log,
              d_skip, g_ssm, w_o_a, w_o_b, w_o):
    y_prompt, y_sample = x_prompt, x_sample
    pk128, pk512, pk2048, pconv, pssm = [], [], [], [], []
    sk128, sk512, sk2048, sconv, sssm = [], [], [], [], []
    for i in range(DEPTH):
        lw = (w_ada[i], b_ada[i], g_pre[i], g_post[i], w_in[i], conv_w[i], conv_b[i], dt_bias[i], a_log[i],
              d_skip[i], g_ssm[i], w_o_a[i], w_o_b[i], w_o[i])
        b_p = x_prompt.shape[0]
        conv0 = jnp.zeros((b_p, SSM_CONV_W - 1, SSM_CONV_DIM), x_prompt.dtype)
        ssm0 = jnp.zeros((b_p, SSM_HEADS, SSM_HEAD_DIM, SSM_D_STATE), x_prompt.dtype)
        y_prompt, bufs_p, conv_p, ssm_p = _layer(y_prompt, c_prompt, None, conv0, ssm0, False, *lw)
        y_sample, bufs_s, conv_s, ssm_s = _layer(
            y_sample, c_sample, (cache_a_w128[i], cache_a_w512[i], cache_a_w2048[i]),
            state_conv[i], state_ssm[i], True, *lw)
        pk128.append(bufs_p[0]); pk512.append(bufs_p[1]); pk2048.append(bufs_p[2])
        pconv.append(conv_p); pssm.append(ssm_p)
        sk128.append(bufs_s[0]); sk512.append(bufs_s[1]); sk2048.append(bufs_s[2])
        sconv.append(conv_s); sssm.append(ssm_s)
    p_kv128, p_kv512, p_kv2048 = jnp.stack(pk128), jnp.stack(pk512), jnp.stack(pk2048)
    p_conv, p_ssm = jnp.stack(pconv), jnp.stack(pssm)
    s_kv128, s_kv512, s_kv2048 = jnp.stack(sk128), jnp.stack(sk512), jnp.stack(sk2048)
    s_conv, s_ssm = jnp.stack(sconv), jnp.stack(sssm)
    return (y_prompt, y_sample, p_kv128, p_kv512, p_kv2048, p_conv, p_ssm, s_kv128, s_kv512, s_kv2048, s_conv, s_ssm)
```

```cpp
#include <hip/hip_runtime.h>
#include <cstdio>
#include <cstdint>

#ifndef MK_N_LAUNCHES
#define MK_N_LAUNCHES 1
#endif

#ifndef REP_P0
#define REP_P0 1
#endif
#ifndef REP_P2
#define REP_P2 1
#endif
#ifndef REP_SSD
#define REP_SSD 1
#endif
#ifndef REP_ATT
#define REP_ATT 1
#endif
#ifndef REP_DEC
#define REP_DEC 1
#endif
#ifndef REP_P56
#define REP_P56 1
#endif
#ifndef REP_LIGHT
#define REP_LIGHT 1
#endif

#define GAS __attribute__((address_space(1)))
#define LAS __attribute__((address_space(3)))
typedef unsigned short bf16_t;
typedef short bf16x8 __attribute__((ext_vector_type(8)));
typedef short s16x4 __attribute__((ext_vector_type(4)));
typedef float f32x4 __attribute__((ext_vector_type(4)));
typedef float f32x2 __attribute__((ext_vector_type(2)));
typedef unsigned u32x4 __attribute__((ext_vector_type(4)));
typedef unsigned u32x2 __attribute__((ext_vector_type(2)));

constexpr int DM = 2048, MP = 16384, MD = 256, MT = MP + MD;
constexpr int NP = 20736;
constexpr int NIN = 20512;
constexpr int C_Q = 0, C_K = 3072, C_V = 6144, C_ZA = 9216, C_ZB = 10240, C_XBC = 12288, C_RA = 16384, C_RB = 18432, C_DT = 20480;
constexpr int KAB = 3072;
constexpr float ATT_SCALE = 0.08838834764831845f;
constexpr float NORM_EPS = 1e-6f;

constexpr size_t O_YP = 0, O_YS = 33554432, O_PKV128 = O_YS + 524288, O_PKV512 = O_PKV128 + 1048576, O_PKV2048 = O_PKV512 + 4194304,
                 O_PCONV = O_PKV2048 + 16777216, O_PSSM = O_PCONV + 49152, O_SKV128 = O_PSSM + 1048576, O_SKV512 = O_SKV128 + 8388608,
                 O_SKV2048 = O_SKV512 + 33554432, O_SCONV = O_SKV2048 + 134217728, O_SSSM = O_SCONV + 393216, O_END = O_SSSM + 8388608;

constexpr size_t MiB = 1u << 20;
constexpr size_t WS_CTL = 0, CTL_ZERO_BYTES = 1 * MiB;
constexpr size_t WS_MOD = 1 * MiB;
constexpr size_t WS_WIN = 2 * MiB;
constexpr size_t WS_WAB = 83 * MiB;
constexpr size_t WS_WO = 95 * MiB;
constexpr size_t WS_H = 103 * MiB;
constexpr size_t WS_DT = 168 * MiB;
constexpr size_t WS_LSE = 171 * MiB;
constexpr size_t WS_PROJ = 173 * MiB;
constexpr size_t WS_OG = 832 * MiB;
constexpr size_t WS_YG = 930 * MiB;
constexpr size_t WS_AY = 995 * MiB;
constexpr size_t WS_TMP = 1093 * MiB;
constexpr size_t WS_XBCA = WS_TMP;
constexpr size_t WS_MRG = 1223 * MiB;
constexpr size_t WS_KVC = WS_MRG;
constexpr size_t WS_OUT = 1288 * MiB;
constexpr size_t WS_OUTD = 1420 * MiB;
constexpr size_t WS_DUMMY = 1418 * MiB;
constexpr size_t WS_END = 1423 * MiB;
constexpr int CW_BAR = 4096;

constexpr int LDS_BYTES = 163840;
constexpr int MISC_OFF = 163584;

__device__ __forceinline__ unsigned cvt_pk_bf16(float lo, float hi) { unsigned r; asm volatile("v_cvt_pk_bf16_f32 %0, %1, %2" : "=v"(r) : "v"(lo), "v"(hi)); return r; }
__device__ __forceinline__ float bf_lo(unsigned w) { return __uint_as_float(w << 16); }
__device__ __forceinline__ float bf_hi(unsigned w) { return __uint_as_float(w & 0xffff0000u); }
__device__ __forceinline__ float bf2f(unsigned short b) { return __uint_as_float(((unsigned)b) << 16); }
__device__ __forceinline__ unsigned short f2bf(float f) { return (unsigned short)(cvt_pk_bf16(f, 0.f) & 0xffffu); }
__device__ __forceinline__ s16x4 pack4(float a, float b, float c, float d) { u32x2 w; w.x = cvt_pk_bf16(a, b); w.y = cvt_pk_bf16(c, d); return __builtin_bit_cast(s16x4, w); }
__device__ __forceinline__ bf16x8 cat8(s16x4 lo, s16x4 hi) { return __builtin_shufflevector(lo, hi, 0, 1, 2, 3, 4, 5, 6, 7); }
__device__ __forceinline__ float silu_f(float x) { return x * __builtin_amdgcn_rcpf(1.f + __expf(-x)); }
__device__ __forceinline__ float sigmoid_f(float x) { return __builtin_amdgcn_rcpf(1.f + __expf(-x)); }
__device__ __forceinline__ float softplus_f(float x) { return x > 20.f ? x : log1pf(expf(x)); }
__device__ __forceinline__ float wave_sum(float v) {
#pragma unroll
    for (int o = 1; o < 64; o <<= 1) v += __shfl_xor(v, o);
    return v;
}
typedef short v4i16_t __attribute__((ext_vector_type(4)));
__device__ __forceinline__ s16x4 vtr(LAS unsigned char* p) { return __builtin_bit_cast(s16x4, __builtin_amdgcn_ds_read_tr16_b64_v4i16((LAS v4i16_t*)p)); }
#define MFMA16(a, b, c) __builtin_amdgcn_mfma_f32_16x16x32_bf16((a), (b), (c), 0, 0, 0)
#define LDS_WAIT() asm volatile("s_waitcnt lgkmcnt(0)" ::: "memory")

namespace pg8 {
constexpr int BM = 256, BK = 64, HALF = 128, HTB = HALF * BK * 2, STAGE_BYTES = 8 * HTB, NXCD = 8, WGM = 8;
__host__ __device__ __forceinline__ int lds_byte(int r, int c) { const int st = (r >> 4) * 2 + (c >> 5), rr = r & 15, cc = c & 31, ob = rr * 64 + cc * 2; return st * 1024 + (ob ^ (((ob >> 9) & 1) << 5)); }
__host__ __device__ __forceinline__ void stage_rc(int b, int& R, int& C) { const int st = b / 1024, sb = b % 1024, swz = sb ^ (((sb >> 9) & 1) << 5); R = (st >> 1) * 16 + swz / 64; C = (st & 1) * 32 + (swz % 64) / 2; }
__host__ __device__ __forceinline__ int perm32(int rho) { const int n = rho >> 4, i = rho & 15; return 8 * (i >> 2) + 4 * n + (i & 3); }

struct Unit { int pm, pn, L; };
struct Gemm { const GAS bf16_t* A; const GAS bf16_t* Bt; int M, N, K, lda, ldb; };


constexpr int KVC_G0 = 32 * 128, KVC_G1 = KVC_G0 + 32 * 512, KVC_ROWS = KVC_G1 + 32 * 2048;
__device__ __forceinline__ void kvc_row(int R, const char* s0, const char* s1, const char* s2, char* dbase, const GAS f32x4*& src, GAS f32x4*& dst) {
    const char* sb = R < KVC_G0 ? s0 : (R < KVC_G1 ? s1 : s2);
    const int dg = R < KVC_G0 ? R : (R < KVC_G1 ? R - KVC_G0 : R - KVC_G1), gl = R < KVC_G0 ? KVC_G0 - 1 : (R < KVC_G1 ? 32 * 512 - 1 : 32 * 2048 - 1);
    const int sr = dg + 8 < gl ? dg + 8 : gl;
    src = (const GAS f32x4*)(sb + (size_t)sr * 8192); dst = (GAS f32x4*)(dbase + (size_t)R * 8192);
}

struct NoSide { static constexpr bool ACTIVE = false; __device__ __forceinline__ void step(int, int) {} __device__ __forceinline__ void finish() {} };
struct SideKvCopy {
    static constexpr bool ACTIVE = true;
    f32x4 v; GAS f32x4* dprev; unsigned voff; const char* s0; const char* s1; const char* s2; char* dbase;
    __device__ __forceinline__ void init(GAS f32x4* dummy, const void* c0, const void* c1, const void* c2, float* out) {
        v = (f32x4){0.f, 0.f, 0.f, 0.f}; dprev = dummy; voff = threadIdx.x * 16u; s0 = (const char*)c0; s1 = (const char*)c1; s2 = (const char*)c2; dbase = (char*)(out + O_SKV128); }
    __device__ __forceinline__ void step(int L, int j) {
        asm volatile("global_store_dwordx4 %0, %1, %2 nt" :: "v"(voff), "v"(v), "s"(dprev) : "memory");
        const GAS f32x4* sp; GAS f32x4* dp; kvc_row((L * 16 + j) % KVC_ROWS, s0, s1, s2, dbase, sp, dp);
        asm volatile("global_load_dwordx4 %0, %1, %2 nt" : "=v"(v) : "v"(voff), "s"(sp) : "memory");
        dprev = dp;
    }
    __device__ __forceinline__ void finish() { asm volatile("s_waitcnt vmcnt(0)\n\tglobal_store_dwordx4 %0, %1, %2 nt" :: "v"(voff), "v"(v), "s"(dprev) : "memory"); }
};

struct StaticOrder {
    int nM, nN, nwg, G, c, nrep;
    __host__ __device__ void init(int M, int N, int G_, int c_, int nrep_ = 1) { nM = M / BM; nN = N / BM; nwg = nM * nN; G = G_; c = c_; nrep = nrep_; }
    __host__ __device__ bool next(int i, Unit& u) const {
        const long L = (long)i * G + c; if (L >= (long)nwg * nrep) return false;
        int wgid = (int)(L % nwg); { const int q = nwg / NXCD, r = nwg % NXCD, xcd = wgid % NXCD, off = wgid / NXCD; wgid = (xcd < r ? xcd * (q + 1) : r * (q + 1) + (xcd - r) * q) + off; }
        const int nig = WGM * nN, gid = wgid / nig, fm = gid * WGM, gsz = (nM - fm) < WGM ? (nM - fm) : WGM;
        u.pm = fm + ((wgid % nig) % gsz); u.pn = (wgid % nig) / gsz; u.L = (int)L; return true;
    }
    __device__ __forceinline__ void a_ready(const Unit&) const {}
    __device__ __forceinline__ void done(const Unit&) const {}
};


struct EpiProj {
    static constexpr bool PERM = true, AFTER_DRAIN = false;
    GAS bf16_t* O; int ldc; GAS float* DT; GAS bf16_t* KVC;
    __device__ __forceinline__ void operator()(const f32x4 (&acc)[2][2][4][2], const Unit& u, int wr, int wc, int fr, int fq) const {
        const int row0 = u.pm * BM + wr * 64 + fr;
        if (u.pn == 80) {
            if (wc == 0) {
#pragma unroll
                for (int ai = 0; ai < 2; ++ai)
#pragma unroll
                    for (int m = 0; m < 4; ++m) { GAS float* rp = DT + (size_t)(row0 + ai * HALF + m * 16) * 32 + 8 * fq;
                        *(GAS f32x4*)(rp) = acc[ai][0][m][0]; *(GAS f32x4*)(rp + 4) = acc[ai][0][m][1]; }
            }
        } else if (u.pn >= 12 && u.pn < 36 && u.pm < 64) {
            const int t12 = u.pn - 12, kvsel = t12 >= 12 ? 1 : 0, r12 = t12 - 12 * kvsel, g = r12 >> 2, hq = r12 & 3, sh = 2 * g, dim = wc * 32 + 8 * fq;
#pragma unroll
            for (int ai = 0; ai < 2; ++ai)
#pragma unroll
                for (int m = 0; m < 4; ++m) { const int row = row0 + ai * HALF + m * 16, b = row >> 12, t = row & 4095, ridx = ((t & ((1 << sh) - 1)) << (12 - sh)) + (t >> sh);
#pragma unroll
                    for (int bj = 0; bj < 2; ++bj) { const f32x4 v0 = acc[ai][bj][m][0], v1 = acc[ai][bj][m][1];
                        u32x4 w; w.x = cvt_pk_bf16(v0[0], v0[1]); w.y = cvt_pk_bf16(v0[2], v0[3]); w.z = cvt_pk_bf16(v1[0], v1[1]); w.w = cvt_pk_bf16(v1[2], v1[3]);
                        *(GAS u32x4*)(KVC + ((size_t)((((kvsel * 3 + g) * 4 + b) * 8) + 2 * hq + bj) << 19) + (size_t)ridx * 128 + dim) = w; } }
        } else {
            const int col0 = u.pn * BM + wc * 32 + 8 * fq;
#pragma unroll
            for (int ai = 0; ai < 2; ++ai)
#pragma unroll
                for (int m = 0; m < 4; ++m) { GAS bf16_t* rowp = O + (size_t)(row0 + ai * HALF + m * 16) * ldc + col0;
#pragma unroll
                    for (int bj = 0; bj < 2; ++bj) { const f32x4 v0 = acc[ai][bj][m][0], v1 = acc[ai][bj][m][1];
                        u32x4 w; w.x = cvt_pk_bf16(v0[0], v0[1]); w.y = cvt_pk_bf16(v0[2], v0[3]); w.z = cvt_pk_bf16(v1[0], v1[1]); w.w = cvt_pk_bf16(v1[2], v1[3]);
                        *(GAS u32x4*)(rowp + bj * HALF) = w; } }
        }
    }
};
struct EpiGateA {
    static constexpr bool PERM = true, AFTER_DRAIN = false;
    const GAS bf16_t* gate; int ldg; GAS bf16_t* T;
    __device__ __forceinline__ void operator()(const f32x4 (&acc)[2][2][4][2], const Unit& u, int wr, int wc, int fr, int fq) const {
        const int row0 = u.pm * BM + wr * 64 + fr, col0 = u.pn * BM + wc * 32 + 8 * fq;
#pragma unroll
        for (int ai = 0; ai < 2; ++ai)
#pragma unroll
            for (int m = 0; m < 4; ++m) { const size_t row = (size_t)(row0 + ai * HALF + m * 16);
#pragma unroll
                for (int bj = 0; bj < 2; ++bj) { const int col = col0 + bj * HALF;
                    const u32x4 gw = *(const GAS u32x4*)(gate + row * ldg + col);
                    f32x4 v0 = acc[ai][bj][m][0], v1 = acc[ai][bj][m][1];
                    v0[0] *= sigmoid_f(bf_lo(gw.x)); v0[1] *= sigmoid_f(bf_hi(gw.x)); v0[2] *= sigmoid_f(bf_lo(gw.y)); v0[3] *= sigmoid_f(bf_hi(gw.y));
                    v1[0] *= sigmoid_f(bf_lo(gw.z)); v1[1] *= sigmoid_f(bf_hi(gw.z)); v1[2] *= sigmoid_f(bf_lo(gw.w)); v1[3] *= sigmoid_f(bf_hi(gw.w));
                    u32x4 w; w.x = cvt_pk_bf16(v0[0], v0[1]); w.y = cvt_pk_bf16(v0[2], v0[3]); w.z = cvt_pk_bf16(v1[0], v1[1]); w.w = cvt_pk_bf16(v1[2], v1[3]);
                    *(GAS u32x4*)(T + row * DM + col) = w; } }
    }
};
struct EpiGateB {
    static constexpr bool PERM = true, AFTER_DRAIN = false;
    const GAS bf16_t* gate; int ldg; const GAS bf16_t* T; GAS bf16_t* O;
    __device__ __forceinline__ void operator()(const f32x4 (&acc)[2][2][4][2], const Unit& u, int wr, int wc, int fr, int fq) const {
        const int row0 = u.pm * BM + wr * 64 + fr, col0 = u.pn * BM + wc * 32 + 8 * fq;
#pragma unroll
        for (int ai = 0; ai < 2; ++ai)
#pragma unroll
            for (int m = 0; m < 4; ++m) { const size_t row = (size_t)(row0 + ai * HALF + m * 16);
#pragma unroll
                for (int bj = 0; bj < 2; ++bj) { const int col = col0 + bj * HALF;
                    const u32x4 gw = *(const GAS u32x4*)(gate + row * ldg + col);
                    const u32x4 tw = *(const GAS u32x4*)(T + row * DM + col);
                    f32x4 v0 = acc[ai][bj][m][0], v1 = acc[ai][bj][m][1];
                    v0[0] = bf_lo(tw.x) + v0[0] * sigmoid_f(bf_lo(gw.x)); v0[1] = bf_hi(tw.x) + v0[1] * sigmoid_f(bf_hi(gw.x)); v0[2] = bf_lo(tw.y) + v0[2] * sigmoid_f(bf_lo(gw.y)); v0[3] = bf_hi(tw.y) + v0[3] * sigmoid_f(bf_hi(gw.y));
                    v1[0] = bf_lo(tw.z) + v1[0] * sigmoid_f(bf_lo(gw.z)); v1[1] = bf_hi(tw.z) + v1[1] * sigmoid_f(bf_hi(gw.z)); v1[2] = bf_lo(tw.w) + v1[2] * sigmoid_f(bf_lo(gw.w)); v1[3] = bf_hi(tw.w) + v1[3] * sigmoid_f(bf_hi(gw.w));
                    u32x4 w; w.x = cvt_pk_bf16(v0[0], v0[1]); w.y = cvt_pk_bf16(v0[2], v0[3]); w.z = cvt_pk_bf16(v1[0], v1[1]); w.w = cvt_pk_bf16(v1[2], v1[3]);
                    *(GAS u32x4*)(O + row * DM + col) = w; } }
    }
};
struct EpiOutBf16 {
    static constexpr bool PERM = true, AFTER_DRAIN = false;
    GAS bf16_t* O; int ldc;
    __device__ __forceinline__ void operator()(const f32x4 (&acc)[2][2][4][2], const Unit& u, int wr, int wc, int fr, int fq) const {
        const int row0 = u.pm * BM + wr * 64 + fr, col0 = u.pn * BM + wc * 32 + 8 * fq;
#pragma unroll
        for (int ai = 0; ai < 2; ++ai)
#pragma unroll
            for (int m = 0; m < 4; ++m) { GAS bf16_t* rowp = O + (size_t)(row0 + ai * HALF + m * 16) * ldc + col0;
#pragma unroll
                for (int bj = 0; bj < 2; ++bj) { const f32x4 v0 = acc[ai][bj][m][0], v1 = acc[ai][bj][m][1];
                    u32x4 w; w.x = cvt_pk_bf16(v0[0], v0[1]); w.y = cvt_pk_bf16(v0[2], v0[3]); w.z = cvt_pk_bf16(v1[0], v1[1]); w.w = cvt_pk_bf16(v1[2], v1[3]);
                    *(GAS u32x4*)(rowp + bj * HALF) = w; } }
    }
};
struct EpiF32 {
    static constexpr bool PERM = false, AFTER_DRAIN = false;
    GAS float* C; int ldc;
    __device__ __forceinline__ void operator()(const f32x4 (&acc)[2][2][4][2], const Unit& u, int wr, int wc, int fr, int fq) const {
        const int row0 = u.pm * BM + wr * 64 + fr, col0 = u.pn * BM + wc * 32 + 4 * fq;
#pragma unroll
        for (int ai = 0; ai < 2; ++ai)
#pragma unroll
            for (int m = 0; m < 4; ++m) { GAS float* rowp = C + (size_t)(row0 + ai * HALF + m * 16) * ldc + col0;
#pragma unroll
                for (int bj = 0; bj < 2; ++bj)
#pragma unroll
                    for (int n = 0; n < 2; ++n) *(GAS f32x4*)(rowp + bj * HALF + n * 16) = acc[ai][bj][m][n]; }
    }
};

template <class Epi, class Sched, bool ALIGN_EPI = false, bool SP2 = false, class Side = NoSide>
__device__ __forceinline__ void gemm_phase(LAS unsigned char* lds, const Gemm g, const Sched& S, const Epi& E, Side side = Side()) {
    const int tid = threadIdx.x, wid = __builtin_amdgcn_readfirstlane(tid >> 6), lane = tid & 63, wr = wid >> 2, wc = wid & 3, fr = lane & 15, fq = lane >> 4;
    const int K = g.K, nt = K / BK;
    unsigned voffA[2], voffB[2];
#pragma unroll
    for (int i = 0; i < 2; ++i) { int R, C; stage_rc(tid * 16 + i * 8192, R, C); const int Rb = Epi::PERM ? ((R & ~31) + perm32(R & 31)) : R;
        voffA[i] = (unsigned)(R * g.lda + C) * 2u; voffB[i] = (unsigned)(Rb * g.ldb + C) * 2u; }
    const size_t kstep = (size_t)(BK * 2);
    const size_t hstepA = (size_t)HALF * g.lda * 2, hstepB = (size_t)HALF * g.ldb * 2;
    const size_t tstepA = 2 * hstepA, tstepB = 2 * hstepB;
    const unsigned ldsw = (unsigned)wid * 1024u;
    const int aoff = lds_byte(wr * 64 + fr, fq * 8), boff = lds_byte(wc * 32 + fr, fq * 8);
#define PG8_SA(b, h) (((b) * 2 + (h)) * HTB)
#define PG8_SB(b, h) ((4 + (b) * 2 + (h)) * HTB)
#define PG8_STAGE(bufoff, gbase, voff) do { _Pragma("unroll") for (int _i = 0; _i < 2; ++_i) \
        __builtin_amdgcn_global_load_lds((const GAS unsigned*)((gbase) + (voff)[_i]), (LAS unsigned*)(lds + (bufoff) + ldsw + _i * 8192), 16, 0, 0); } while (0)
#define PG8_LDA(dst, b, h) do { _Pragma("unroll") for (int m = 0; m < 4; ++m) _Pragma("unroll") for (int k = 0; k < 2; ++k) dst[m][k] = *(const LAS bf16x8*)(lds + PG8_SA(b, h) + aoff + m * 2048 + k * 1024); } while (0)
#define PG8_LDB(dst, b, h) do { _Pragma("unroll") for (int n = 0; n < 2; ++n) _Pragma("unroll") for (int k = 0; k < 2; ++k) dst[n][k] = *(const LAS bf16x8*)(lds + PG8_SB(b, h) + boff + n * 2048 + k * 1024); } while (0)
#define PG8_MMA(ai, bj, At, Bt) do { __builtin_amdgcn_s_setprio(1); _Pragma("unroll") for (int m = 0; m < 4; ++m) _Pragma("unroll") for (int n = 0; n < 2; ++n) _Pragma("unroll") for (int k = 0; k < 2; ++k) \
        acc[ai][bj][m][n] = __builtin_amdgcn_mfma_f32_16x16x32_bf16(Bt[n][k], At[m][k], acc[ai][bj][m][n], 0, 0, 0); __builtin_amdgcn_s_setprio(0); } while (0)
#define PG8_WAIT_V(n) asm volatile("s_waitcnt vmcnt(" #n ")" ::: "memory")
#define PG8_WAIT_L(n) asm volatile("s_waitcnt lgkmcnt(" #n ")" ::: "memory")
#define PG8_BAR __builtin_amdgcn_s_barrier()
#define PG8_SCHED __builtin_amdgcn_sched_barrier(0)
    Unit cur, nxt; int ui = 0;
    if (!S.next(0, cur)) return;
    f32x4 acc[2][2][4][2];
#pragma unroll
    for (int a = 0; a < 2; ++a)
#pragma unroll
        for (int b = 0; b < 2; ++b)
#pragma unroll
            for (int m = 0; m < 4; ++m)
#pragma unroll
                for (int n = 0; n < 2; ++n) acc[a][b][m][n] = (f32x4){0.f, 0.f, 0.f, 0.f};
    bf16x8 At[4][2], B0[2][2], B1[2][2];
    const GAS char* cA = (const GAS char*)g.A + (size_t)cur.pm * tstepA; const GAS char* cB = (const GAS char*)g.Bt + (size_t)cur.pn * tstepB;
    S.a_ready(cur);
    if constexpr (SP2) {
        PG8_STAGE(PG8_SB(0, 0), cB, voffB); PG8_STAGE(PG8_SB(0, 1), cB + hstepB, voffB); PG8_STAGE(PG8_SA(0, 0), cA, voffA); PG8_STAGE(PG8_SA(0, 1), cA + hstepA, voffA);
        if (wr == 1) PG8_BAR;
        PG8_WAIT_V(2); PG8_BAR;
        PG8_STAGE(PG8_SB(1, 0), cB + kstep, voffB); PG8_STAGE(PG8_SA(1, 0), cA + kstep, voffA); PG8_STAGE(PG8_SB(1, 1), cB + hstepB + kstep, voffB);
        PG8_WAIT_V(6); PG8_BAR;
    } else {
        PG8_STAGE(PG8_SB(0, 0), cB, voffB); PG8_STAGE(PG8_SA(0, 0), cA, voffA); PG8_STAGE(PG8_SB(0, 1), cB + hstepB, voffB); PG8_STAGE(PG8_SA(0, 1), cA + hstepA, voffA);
        if (wr == 1) PG8_BAR;
        PG8_WAIT_V(4); PG8_BAR;
        PG8_STAGE(PG8_SB(1, 0), cB + kstep, voffB); PG8_STAGE(PG8_SA(1, 0), cA + kstep, voffA); PG8_STAGE(PG8_SB(1, 1), cB + hstepB + kstep, voffB);
        PG8_WAIT_V(6); PG8_BAR;
    }
    for (;;) {
        const bool has_next = S.next(ui + 1, nxt);
        const GAS char* nA = has_next ? (const GAS char*)g.A + (size_t)nxt.pm * tstepA : cA; const GAS char* nB = has_next ? (const GAS char*)g.Bt + (size_t)nxt.pn * tstepB : cB;
        for (int t = 0; t < nt; t += 2) {
            const bool last = (t == nt - 2);
            const GAS char* a1 = cA + (size_t)(t + 1) * kstep;
            const GAS char* a2 = last ? nA : cA + (size_t)(t + 2) * kstep; const GAS char* b2 = last ? nB : cB + (size_t)(t + 2) * kstep;
            const GAS char* a3 = a2 + kstep; const GAS char* b3 = b2 + kstep;
            if (last && has_next) S.a_ready(nxt);
            if constexpr (SP2) {
            PG8_LDB(B0, 0, 0); PG8_LDB(B1, 0, 1); PG8_SCHED; PG8_LDA(At, 0, 0); PG8_STAGE(PG8_SA(1, 1), a1 + hstepA, voffA);
            PG8_WAIT_V(8); PG8_WAIT_L(0); PG8_BAR; PG8_MMA(0, 0, At, B0); PG8_MMA(0, 1, At, B1); PG8_BAR; PG8_SCHED;
            PG8_LDA(At, 0, 1); PG8_STAGE(PG8_SB(0, 0), b2, voffB); PG8_STAGE(PG8_SB(0, 1), b2 + hstepB, voffB); PG8_STAGE(PG8_SA(0, 0), a2, voffA);
            if constexpr (Side::ACTIVE) { side.step(cur.L, t >> 1); PG8_WAIT_V(10); } else { PG8_WAIT_V(8); }
            PG8_WAIT_L(0); PG8_BAR; PG8_MMA(1, 0, At, B0); PG8_MMA(1, 1, At, B1); PG8_BAR; PG8_SCHED;
            PG8_LDB(B0, 1, 0); PG8_LDB(B1, 1, 1); PG8_SCHED; PG8_LDA(At, 1, 0); PG8_STAGE(PG8_SA(0, 1), a2 + hstepA, voffA);
            if constexpr (Side::ACTIVE) { PG8_WAIT_V(10); } else { PG8_WAIT_V(8); }
            PG8_WAIT_L(0); PG8_BAR; PG8_MMA(0, 0, At, B0); PG8_MMA(0, 1, At, B1); PG8_BAR; PG8_SCHED;
            PG8_LDA(At, 1, 1); PG8_STAGE(PG8_SB(1, 0), b3, voffB); PG8_STAGE(PG8_SB(1, 1), b3 + hstepB, voffB); PG8_STAGE(PG8_SA(1, 0), a3, voffA);
            PG8_WAIT_V(8); PG8_WAIT_L(0); PG8_BAR; PG8_MMA(1, 0, At, B0); PG8_MMA(1, 1, At, B1); PG8_BAR; PG8_SCHED;
            } else {
            PG8_LDB(B0, 0, 0); PG8_SCHED; PG8_LDA(At, 0, 0); PG8_STAGE(PG8_SA(1, 1), a1 + hstepA, voffA);
            PG8_WAIT_L(8); PG8_BAR; PG8_WAIT_L(0); PG8_MMA(0, 0, At, B0); PG8_BAR; PG8_SCHED;
            PG8_LDB(B1, 0, 1); PG8_STAGE(PG8_SB(0, 0), b2, voffB);
            PG8_BAR; PG8_WAIT_L(0); PG8_MMA(0, 1, At, B1); PG8_BAR;
            PG8_LDA(At, 0, 1); PG8_STAGE(PG8_SA(0, 0), a2, voffA);
            PG8_BAR; PG8_WAIT_L(0); PG8_MMA(1, 0, At, B0); PG8_BAR; PG8_SCHED;
            PG8_STAGE(PG8_SB(0, 1), b2 + hstepB, voffB);
            PG8_WAIT_V(6); PG8_BAR; PG8_MMA(1, 1, At, B1); PG8_BAR;
            PG8_LDB(B0, 1, 0); PG8_SCHED; PG8_LDA(At, 1, 0); PG8_STAGE(PG8_SA(0, 1), a2 + hstepA, voffA);
            PG8_WAIT_L(8); PG8_BAR; PG8_WAIT_L(0); PG8_MMA(0, 0, At, B0); PG8_BAR; PG8_SCHED;
            PG8_LDB(B1, 1, 1); PG8_STAGE(PG8_SB(1, 0), b3, voffB);
            PG8_BAR; PG8_WAIT_L(0); PG8_MMA(0, 1, At, B1); PG8_BAR;
            PG8_LDA(At, 1, 1); PG8_STAGE(PG8_SA(1, 0), a3, voffA);
            PG8_BAR; PG8_WAIT_L(0); PG8_MMA(1, 0, At, B0); PG8_BAR; PG8_SCHED;
            PG8_STAGE(PG8_SB(1, 1), b3 + hstepB, voffB);
            PG8_WAIT_V(6); PG8_BAR; PG8_MMA(1, 1, At, B1); PG8_BAR;
            }
        }
        if constexpr (ALIGN_EPI) { if (wr == 0) PG8_BAR; }
        if constexpr (!Epi::AFTER_DRAIN) { E(acc, cur, wr, wc, fr, fq); S.done(cur); }
        if (!has_next) break;
#pragma unroll
        for (int a = 0; a < 2; ++a)
#pragma unroll
            for (int b = 0; b < 2; ++b)
#pragma unroll
                for (int m = 0; m < 4; ++m)
#pragma unroll
                    for (int n = 0; n < 2; ++n) acc[a][b][m][n] = (f32x4){0.f, 0.f, 0.f, 0.f};
        cur = nxt; cA = nA; cB = nB; ++ui;
        if constexpr (ALIGN_EPI) { if (wr == 1) PG8_BAR; }
    }
    PG8_WAIT_V(0);
    if constexpr (Side::ACTIVE) side.finish();
    if constexpr (!ALIGN_EPI) { if (wr == 0) PG8_BAR; }
    PG8_BAR;
#undef PG8_SA
#undef PG8_SB
#undef PG8_STAGE
#undef PG8_LDA
#undef PG8_LDB
#undef PG8_MMA
#undef PG8_WAIT_V
#undef PG8_WAIT_L
#undef PG8_BAR
#undef PG8_SCHED
}
}

#define XB_TMO      128
#define XB_XCNT(j)  (256  + 64 * (j))
#define XB_XSUB(j)  (1280 + 64 * (j))
#define XB_XGEN(j)  (2304 + 64 * (j))
#define XB_TOP      3328
#define XB_TOPGEN   3392
#define XCD_BAR_WORDS 3456
#define XB_SPIN_CAP (1u << 18)

__device__ __forceinline__ unsigned xb_ld(unsigned* p)              { return __hip_atomic_load(p, __ATOMIC_RELAXED, __HIP_MEMORY_SCOPE_AGENT); }
__device__ __forceinline__ unsigned xb_add(unsigned* p, unsigned v) { return __hip_atomic_fetch_add(p, v, __ATOMIC_RELAXED, __HIP_MEMORY_SCOPE_AGENT); }
__device__ __forceinline__ unsigned xb_xcc_id() { return (unsigned)__builtin_amdgcn_s_getreg((3 << 11) | 20) & 0xFu; }
#define XB_SPIN(cond, bar) do { unsigned _sp = 0; while (cond) { __builtin_amdgcn_s_sleep(1); \
    if ((++_sp & 255u) == 0u) { if (xb_ld(&(bar)[XB_TMO])) break; if (_sp > XB_SPIN_CAP) { atomicAdd(&(bar)[XB_TMO], 1u); break; } } } } while (0)

struct XcdBarrier { unsigned* bar; unsigned x; volatile LAS unsigned* st; };

__device__ __forceinline__ XcdBarrier xcd_barrier_post(unsigned* bar, volatile LAS unsigned* st) {
    XcdBarrier b; b.bar = bar; b.x = xb_xcc_id(); b.st = st;
    if (threadIdx.x == 0) (void)xb_add(&bar[XB_XCNT(b.x)], 1u);
    return b;
}
__device__ __forceinline__ void xcd_barrier_complete(unsigned* bar, unsigned x, unsigned& nloc, unsigned& nx) {
    const unsigned G = gridDim.x * gridDim.y * gridDim.z;
    unsigned sum, cnt, mine, sp = 0u;
    for (;;) {
        sum = 0u; cnt = 0u; mine = 0u;
#pragma unroll
        for (unsigned j = 0; j < 16; ++j) { const unsigned c = xb_ld(&bar[XB_XCNT(j)]); sum += c; cnt += (c > 0u) ? 1u : 0u; mine = (j == x) ? c : mine; }
        if (sum == G) break;
        __builtin_amdgcn_s_sleep(1);
        if ((++sp & 255u) == 0u) { if (xb_ld(&bar[XB_TMO])) break; if (sp > XB_SPIN_CAP) { atomicAdd(&bar[XB_TMO], 1u); break; } }
    }
    nloc = mine > 0u ? mine : 1u; nx = cnt > 0u ? cnt : 1u;
}
__device__ __forceinline__ void xcd_barrier(const XcdBarrier& b) {
    asm volatile("s_waitcnt vmcnt(0)" ::: "memory");
    __syncthreads();
    if (threadIdx.x == 0) {
        unsigned* bar = b.bar;
        __builtin_amdgcn_s_waitcnt(0);
        unsigned nloc = b.st[0], nx = b.st[1];
        if (nloc == 0u) { xcd_barrier_complete(bar, b.x, nloc, nx); b.st[0] = nloc; b.st[1] = nx; }
        const unsigned old = xb_add(&bar[XB_XSUB(b.x)], 1u);
        const unsigned gen = old / nloc;
        if (old + 1u == (gen + 1u) * nloc) {
            __builtin_amdgcn_fence(__ATOMIC_RELEASE, "agent");
            asm volatile("s_waitcnt vmcnt(0)" ::: "memory");
            const unsigned og = xb_add(&bar[XB_TOP], 1u);
            const unsigned tg = og / nx;
            if (og + 1u == (tg + 1u) * nx) xb_add(&bar[XB_TOPGEN], 1u);
            else XB_SPIN(xb_ld(&bar[XB_TOPGEN]) == tg, bar);
            __builtin_amdgcn_fence(__ATOMIC_ACQUIRE, "agent");
            xb_add(&bar[XB_XGEN(b.x)], 1u);
            asm volatile("s_waitcnt vmcnt(0)" ::: "memory");
        } else {
            XB_SPIN(xb_ld(&bar[XB_XGEN(b.x)]) == gen, bar);
            __builtin_amdgcn_fence(__ATOMIC_ACQUIRE, "agent");
            asm volatile("s_waitcnt vmcnt(0)" ::: "memory");
        }
    }
    __syncthreads();
}

struct Args { const void* in[23]; float* out; unsigned char* ws; int ph_lo, ph_hi; };

__device__ __forceinline__ unsigned char* fresh_ws(const Args& A) { unsigned char* w = A.ws; asm volatile("" : "+s"(w)); return w; }
struct Ctx {
    LAS unsigned char* lds;
    int tid, lane, wave, bid, G;
};

__device__ __forceinline__ void tr_item(const GAS float* W, int ldw, int src_n0, int k0, GAS bf16_t* WT, int ldt, int dst_n0, int dst_k0, LAS float* scr, int lane) {
    const int c = lane & 7;
    if (src_n0 < 0) {
#pragma unroll
        for (int j = 0; j < 4; ++j) { const int n = (lane >> 3) + 8 * j; *(GAS u32x4*)(WT + (size_t)(dst_n0 + n) * ldt + dst_k0 + k0 + 8 * c) = (u32x4){0u, 0u, 0u, 0u}; }
        return;
    }
#pragma unroll 8
    for (int i = 0; i < 32; ++i) { const int kk = 2 * i + (lane >> 5); scr[kk * 33 + (lane & 31)] = W[(size_t)(k0 + kk) * ldw + src_n0 + (lane & 31)]; }
    LDS_WAIT(); asm volatile("" ::: "memory");
#pragma unroll
    for (int j = 0; j < 4; ++j) { const int n = (lane >> 3) + 8 * j; const LAS float* s = scr + (8 * c) * 33 + n;
        u32x4 o; o.x = cvt_pk_bf16(s[0 * 33], s[1 * 33]); o.y = cvt_pk_bf16(s[2 * 33], s[3 * 33]); o.z = cvt_pk_bf16(s[4 * 33], s[5 * 33]); o.w = cvt_pk_bf16(s[6 * 33], s[7 * 33]);
        *(GAS u32x4*)(WT + (size_t)(dst_n0 + n) * ldt + dst_k0 + k0 + 8 * c) = o; }
    LDS_WAIT(); asm volatile("" ::: "memory");
}

__device__ __forceinline__ void mod_item(const Ctx& X, const GAS float* cp, const GAS float* cs, const GAS float* w_ada, const GAS float* b_ada, GAS float* mod, int it) {
    LAS float* sc = (LAS float*)X.lds;
    LAS float* red = (LAS float*)(X.lds + 36864);
    const int tid = X.tid, col = tid & 31, kg = tid >> 5, n = it * 32 + col;
    f32x2 acc[18];
#pragma unroll
    for (int r = 0; r < 18; ++r) acc[r] = (f32x2){0.f, 0.f};
    float wn[16], cn[18];
#define MOD_LOAD(slab_) do { _Pragma("unroll") for (int kk = 0; kk < 16; ++kk) wn[kk] = w_ada[(size_t)((slab_) * 256 + kg * 16 + kk) * 6144 + n]; \
        _Pragma("unroll") for (int q = 0; q < 18; ++q) { const int e = tid + 512 * q, r = e >> 8, k = e & 255; cn[q] = (r < 4) ? cp[r * DM + (slab_) * 256 + k] : cs[(r - 4) * DM + (slab_) * 256 + k]; } } while (0)
    MOD_LOAD(0);
    for (int slab = 0; slab < 8; ++slab) {
        __syncthreads();
#pragma unroll
        for (int q = 0; q < 18; ++q) { const int e = tid + 512 * q, r = e >> 8, k = e & 255; sc[k * 36 + r] = silu_f(cn[q]); }
        float wc[16];
#pragma unroll
        for (int kk = 0; kk < 16; ++kk) wc[kk] = wn[kk];
        if (slab + 1 < 8) MOD_LOAD(slab + 1);
        __syncthreads();
#pragma unroll
        for (int kk = 0; kk < 16; ++kk) { const int k = kg * 16 + kk; const float w = wc[kk];
            const LAS f32x4* s4 = (const LAS f32x4*)(sc + k * 36);
#pragma unroll
            for (int r4 = 0; r4 < 9; ++r4) { const f32x4 v = s4[r4]; const f32x2 ww = (f32x2){w, w};
                acc[2 * r4] = __builtin_elementwise_fma((f32x2){v[0], v[1]}, ww, acc[2 * r4]); acc[2 * r4 + 1] = __builtin_elementwise_fma((f32x2){v[2], v[3]}, ww, acc[2 * r4 + 1]); } }
    }
#undef MOD_LOAD
#pragma unroll
    for (int r = 0; r < 36; ++r) red[(kg * 36 + r) * 32 + col] = acc[r >> 1][r & 1];
    __syncthreads();
    for (int e = tid; e < 36 * 32; e += 512) { const int r = e >> 5, c = e & 31; float s = 0.f;
#pragma unroll
        for (int q = 0; q < 16; ++q) s += red[(q * 36 + r) * 32 + c];
        mod[r * 6144 + it * 32 + c] = s + b_ada[it * 32 + c]; }
    __syncthreads();
}

__device__ __forceinline__ void phase0(const Ctx& X, const Args& A) {
    unsigned char* const wsl = fresh_ws(A);
    unsigned char* ws = wsl;
    const GAS float* w_in = (const GAS float*)A.in[13];
    GAS bf16_t* WIN = (GAS bf16_t*)(ws + WS_WIN);
    LAS float* scr = (LAS float*)(X.lds + X.wave * 8448);
    const int gw = X.bid * 8 + X.wave, NGW = X.G * 8;
    constexpr int NB_IN = NP / 32, I_IN = 32 * NB_IN;
    for (int it = gw; it < I_IN; it += NGW) {
        const int kb = it / NB_IN, nb = it % NB_IN, n0 = nb * 32;
        const int src = n0 < 16384 ? n0 : (n0 < C_DT ? n0 + 32 : (n0 < C_DT + 32 ? 16384 : -1));
        tr_item(w_in, NIN, src, kb * 64, WIN, DM, n0, 0, scr, X.lane);
    }
    for (int it = X.bid; it < 192; it += X.G)
        mod_item(X, (const GAS float*)A.in[7], (const GAS float*)A.in[8], (const GAS float*)A.in[9], (const GAS float*)A.in[10], (GAS float*)(ws + WS_MOD), it);
}

__device__ __forceinline__ void late_weight_transposes(const Ctx& X, const Args& A, int first_wg) {
    unsigned char* const wsl = fresh_ws(A);
    const GAS float* w_o_a = (const GAS float*)A.in[20]; const GAS float* w_o_b = (const GAS float*)A.in[21]; const GAS float* w_o = (const GAS float*)A.in[22];
    GAS bf16_t* WAB = (GAS bf16_t*)(wsl + WS_WAB); GAS bf16_t* WO = (GAS bf16_t*)(wsl + WS_WO);
    LAS float* scr = (LAS float*)(X.lds + X.wave * 8448);
    constexpr int I_OA = 16 * 64, I_OB = 32 * 64, I_O = 32 * 64;
    const int gw = (X.bid - first_wg) * 8 + X.wave, NGW = (X.G - first_wg) * 8;
    for (int it = gw; it < I_OA + I_OB + I_O; it += NGW) {
        int r = it;
        if (r < I_OA) { const int kb = r / 64, nb = r % 64; tr_item(w_o_a, DM, nb * 32, kb * 64, WAB, KAB, nb * 32, 0, scr, X.lane); continue; }
        r -= I_OA;
        if (r < I_OB) { const int kb = r / 64, nb = r % 64; tr_item(w_o_b, DM, nb * 32, kb * 64, WAB, KAB, nb * 32, 1024, scr, X.lane); continue; }
        r -= I_OB;
        { const int kb = r / 64, nb = r % 64; tr_item(w_o, DM, nb * 32, kb * 64, WO, DM, nb * 32, 0, scr, X.lane); }
    }
}

__device__ __forceinline__ void phase1(const Ctx& X, const Args& A) {
    unsigned char* const wsl = fresh_ws(A);
    const GAS float* xp = (const GAS float*)A.in[0]; const GAS float* xs = (const GAS float*)A.in[1]; const GAS float* gpre = (const GAS float*)A.in[11];
    const GAS float* mod = (const GAS float*)(wsl + WS_MOD); GAS bf16_t* H = (GAS bf16_t*)(wsl + WS_H);
    const int gw = X.bid * 8 + X.wave, NGW = X.G * 8, lane = X.lane;
    for (int m = gw; m < MT; m += NGW) {
        const GAS f32x4* xr = (const GAS f32x4*)(m < MP ? xp + (size_t)m * DM : xs + (size_t)(m - MP) * DM);
        const int mb = m < MP ? (m >> 12) : 4 + ((m - MP) >> 3);
        const GAS f32x4* sh4 = (const GAS f32x4*)(mod + mb * 6144); const GAS f32x4* sc4 = sh4 + 512; const GAS f32x4* g4 = (const GAS f32x4*)gpre;
        f32x4 v[8]; float ss = 0.f;
#pragma unroll
        for (int j = 0; j < 8; ++j) v[j] = __builtin_nontemporal_load(xr + lane + 64 * j);
        f32x4 ggv[8], shv[8], scv[8];
#pragma unroll
        for (int j = 0; j < 8; ++j) { ggv[j] = g4[lane + 64 * j]; shv[j] = sh4[lane + 64 * j]; scv[j] = sc4[lane + 64 * j]; }
        __builtin_amdgcn_sched_barrier(0);
#pragma unroll
        for (int j = 0; j < 8; ++j) ss += (v[j][0] * v[j][0] + v[j][1] * v[j][1]) + (v[j][2] * v[j][2] + v[j][3] * v[j][3]);
        const float rstd = rsqrtf(wave_sum(ss) * (1.f / DM) + NORM_EPS);
        GAS u32x2* o = (GAS u32x2*)(H + (size_t)m * DM);
#pragma unroll
        for (int j = 0; j < 8; ++j) { const f32x4 gg = ggv[j], sh = shv[j], sc = scv[j];
            f32x4 y;
#pragma unroll
            for (int e = 0; e < 4; ++e) y[e] = (v[j][e] * rstd * gg[e]) * (1.f + sc[e]) + sh[e];
            u32x2 w; w.x = cvt_pk_bf16(y[0], y[1]); w.y = cvt_pk_bf16(y[2], y[3]); o[lane + 64 * j] = w; }
    }
    { constexpr int R0 = 16 * 65 * 81, NR = (pg8::KVC_ROWS - R0 + 255) / 256;
      for (int Rb = R0 + X.bid; Rb < pg8::KVC_ROWS; Rb += X.G * NR) {
        u32x4 v[NR];
#pragma unroll
        for (int q = 0; q < NR; ++q) { int R = Rb + q * X.G; if (R >= pg8::KVC_ROWS) R = Rb; const GAS f32x4* sp; GAS f32x4* dp; pg8::kvc_row(R, (const char*)A.in[2], (const char*)A.in[3], (const char*)A.in[4], (char*)(A.out + O_SKV128), sp, dp);
            v[q] = *((const GAS u32x4*)sp + X.tid); }
#pragma unroll
        for (int q = 0; q < NR; ++q) { const int R = Rb + q * X.G; if (R < pg8::KVC_ROWS) { const GAS f32x4* sp; GAS f32x4* dp; pg8::kvc_row(R, (const char*)A.in[2], (const char*)A.in[3], (const char*)A.in[4], (char*)(A.out + O_SKV128), sp, dp);
            *((GAS u32x4*)dp + X.tid) = v[q]; } }
      } }
}

__device__ __forceinline__ void unpack8(const u32x4 v, float (&x)[8]) { x[0] = bf_lo(v.x); x[1] = bf_hi(v.x); x[2] = bf_lo(v.y); x[3] = bf_hi(v.y); x[4] = bf_lo(v.z); x[5] = bf_hi(v.z); x[6] = bf_lo(v.w); x[7] = bf_hi(v.w); }
__device__ __forceinline__ void conv_prepass(const Ctx& X, const Args& A) {
    unsigned char* const wsl = fresh_ws(A);
    const GAS bf16_t* proj = (const GAS bf16_t*)(wsl + WS_PROJ); GAS bf16_t* XB = (GAS bf16_t*)(wsl + WS_XBCA); GAS float* DT = (GAS float*)(wsl + WS_DT);
    const GAS float* conv_w = (const GAS float*)A.in[14]; const GAS float* conv_b = (const GAS float*)A.in[15]; const GAS float* hist = (const GAS float*)A.in[5];
    const int gt = X.bid * 512 + X.tid, GT = X.G * 512;
    const int cc = gt & 511, ch0 = cc * 8;
    float wt[4][8], bias[8];
#pragma unroll
    for (int kk = 0; kk < 4; ++kk) { const f32x4 a = *(const GAS f32x4*)(conv_w + kk * 4096 + ch0), b = *(const GAS f32x4*)(conv_w + kk * 4096 + ch0 + 4);
        wt[kk][0] = a[0]; wt[kk][1] = a[1]; wt[kk][2] = a[2]; wt[kk][3] = a[3]; wt[kk][4] = b[0]; wt[kk][5] = b[1]; wt[kk][6] = b[2]; wt[kk][7] = b[3]; }
    { const f32x4 a = *(const GAS f32x4*)(conv_b + ch0), b = *(const GAS f32x4*)(conv_b + ch0 + 4); bias[0] = a[0]; bias[1] = a[1]; bias[2] = a[2]; bias[3] = a[3]; bias[4] = b[0]; bias[5] = b[1]; bias[6] = b[2]; bias[7] = b[3]; }
    for (int run = gt >> 9; run < 1024 + 32; run += GT >> 9) {
        const bool dec = run >= 1024;
        const size_t row_first = dec ? (size_t)MP + (size_t)(run - 1024) * 8 : (size_t)run * 16;
        const int t0 = dec ? 0 : ((run * 16) & 4095), nt = dec ? 8 : 16;
        const GAS bf16_t* src = proj + row_first * NP + C_XBC + ch0;
        float xm[3][8];
        if (t0 >= 3) {
#pragma unroll
            for (int j = 0; j < 3; ++j) unpack8(*(const GAS u32x4*)(src + (long)(j - 3) * NP), xm[j]);
        } else if (dec) {
            const GAS float* hp = hist + (size_t)(run - 1024) * 3 * 4096 + ch0;
#pragma unroll
            for (int j = 0; j < 3; ++j) { const f32x4 a = *(const GAS f32x4*)(hp + j * 4096), b = *(const GAS f32x4*)(hp + j * 4096 + 4);
                xm[j][0] = a[0]; xm[j][1] = a[1]; xm[j][2] = a[2]; xm[j][3] = a[3]; xm[j][4] = b[0]; xm[j][5] = b[1]; xm[j][6] = b[2]; xm[j][7] = b[3]; }
        } else {
#pragma unroll
            for (int j = 0; j < 3; ++j)
#pragma unroll
                for (int e = 0; e < 8; ++e) xm[j][e] = 0.f;
        }
        u32x4 rows[16];
#pragma unroll
        for (int i = 0; i < 16; ++i) rows[i] = (i < nt) ? *(const GAS u32x4*)(src + (size_t)i * NP) : (u32x4){0u, 0u, 0u, 0u};
#pragma unroll
        for (int i = 0; i < 16; ++i) {
            if (i < nt) {
                float cur[8], o[8]; unpack8(rows[i], cur);
#pragma unroll
                for (int e = 0; e < 8; ++e) { o[e] = bias[e] + wt[0][e] * xm[0][e] + wt[1][e] * xm[1][e] + wt[2][e] * xm[2][e] + wt[3][e] * cur[e]; o[e] = silu_f(o[e]);
                    xm[0][e] = xm[1][e]; xm[1][e] = xm[2][e]; xm[2][e] = cur[e]; }
                u32x4 pk; pk.x = cvt_pk_bf16(o[0], o[1]); pk.y = cvt_pk_bf16(o[2], o[3]); pk.z = cvt_pk_bf16(o[4], o[5]); pk.w = cvt_pk_bf16(o[6], o[7]);
                *(GAS u32x4*)(XB + (row_first + i) * 4096 + ch0) = pk;
            }
        }
    }
    const GAS float* dtb = (const GAS float*)A.in[16];
    for (int i0 = gt; i0 < MT * 32; i0 += GT * 5) { float dv[5];
#pragma unroll
        for (int q = 0; q < 5; ++q) { const int i = i0 + q * GT; dv[q] = DT[i < MT * 32 ? i : i0]; }
#pragma unroll
        for (int q = 0; q < 5; ++q) { const int i = i0 + q * GT; if (i < MT * 32) DT[i] = softplus_f(dv[q] + dtb[i & 31]); } }
}

__device__ __forceinline__ float wave_incl_scan(float v, int lane) {
#pragma unroll
    for (int o = 1; o < 64; o <<= 1) { const float t = __shfl_up(v, o); if (lane >= o) v += t; }
    return v;
}
constexpr int T_BM = 0  , T_CM = 65536, T_XD = 98304, T_XW = 118784, T_ST = 139264, T_DTV = 157696, T_CSV = 158720, T_GSV = 159744, T_XS = 160;
__device__ __forceinline__ void ssd_prompt_item64(const Ctx& X, const Args& A, int b, int h) {
    unsigned char* const wsl = fresh_ws(A);
    LAS unsigned char* lds = X.lds;
    const int tid = X.tid, lane = X.lane, w = X.wave, fr = lane & 15, g4 = lane >> 4, gi = h >> 2, q = fr >> 2, pp = fr & 3;
    const GAS bf16_t* proj = (const GAS bf16_t*)(wsl + WS_PROJ); const GAS bf16_t* XB = (const GAS bf16_t*)(wsl + WS_XBCA); const GAS float* DT = (const GAS float*)(wsl + WS_DT); GAS bf16_t* YG = (GAS bf16_t*)(wsl + WS_YG);
    unsigned voff[2];
#pragma unroll
    for (int i = 0; i < 2; ++i) { int R, C; pg8::stage_rc(tid * 16 + i * 8192, R, C); voff[i] = (unsigned)(R * 4096 + C) * 2u; }
    const int lsw = (lane * 16) ^ ((lane >> 5) << 5);
    const unsigned voffc = (unsigned)((16 * w + (lsw >> 6)) * 4096 + ((lsw & 63) >> 1)) * 2u;
    const int lane_base = (fr * 64 + 16 * g4) ^ ((fr >> 3) << 5);
#define SSD_FRAG(base, tile, ks) (*(const LAS bf16x8*)(lds + (base) + ((ks) >> 1) * 16384 + (tile) * 2048 + ((ks) & 1) * 1024 + lane_base))
#define SSD_DMA16(gbase_, voff_, ldsaddr_) asm volatile("s_mov_b32 m0, %2\n\ts_nop 0\n\tglobal_load_lds_dwordx4 %0, %1" :: "v"(voff_), "s"(gbase_), "s"(ldsaddr_) : "memory")
#define SSD_STAGE_B(row0_, buf_) do { const char* gB_ = (const char*)(XB + (size_t)(row0_) * 4096 + 2048 + gi * 128); \
        _Pragma("unroll") for (int kh_ = 0; kh_ < 2; ++kh_) _Pragma("unroll") for (int i_ = 0; i_ < 2; ++i_) \
            SSD_DMA16(gB_ + kh_ * 128, voff[i_], ldsb + (unsigned)(T_BM + (buf_) * 32768 + kh_ * 16384 + w * 1024 + i_ * 8192)); } while (0)
#define SSD_STAGE_C(row0_) do { const char* gC_ = (const char*)(XB + (size_t)(row0_) * 4096 + 3072 + gi * 128); \
        _Pragma("unroll") for (int ks_ = 0; ks_ < 4; ++ks_) \
            SSD_DMA16(gC_ + ks_ * 64, voffc, ldsb + (unsigned)(T_CM + (ks_ >> 1) * 16384 + (2 * w + (ks_ & 1)) * 1024)); } while (0)
    const unsigned ldsb = (unsigned)(size_t)lds;
    __syncthreads();
    const float A_h = -expf(((const GAS float*)A.in[17])[h]), Dh = ((const GAS float*)A.in[18])[h];
    f32x4 sacc[4];
#pragma unroll
    for (int pt = 0; pt < 4; ++pt) sacc[pt] = (f32x4){0.f, 0.f, 0.f, 0.f};
    const int xs0 = tid >> 3, xc8 = tid & 7;
    const unsigned xoff = (unsigned)(xs0 * 4096 + h * 64 + xc8 * 8) * 2u;
    const size_t rowb = (size_t)b * 4096;
    SSD_STAGE_B(rowb, 0); SSD_STAGE_C(rowb);
    u32x4 xr[2];
    { const GAS char* xb = (const GAS char*)(XB + rowb * 4096);
#pragma unroll
      for (int i = 0; i < 2; ++i) xr[i] = *(const GAS u32x4*)(xb + xoff + i * (64 * 8192)); }
    float d0 = 0.f, d1 = 0.f, c0s = 0.f, c1s = 0.f, g0s = 0.f, g1s = 0.f;
    if (w == 0) { d0 = DT[(rowb + lane) * 32 + h]; d1 = DT[(rowb + 64 + lane) * 32 + h];
        c0s = wave_incl_scan(d0 * A_h, lane); c1s = wave_incl_scan(d1 * A_h, lane) + __shfl(c0s, 63);
        g0s = __expf(__shfl(c0s, lane | 15) - c0s); g1s = __expf(__shfl(c1s, lane | 15) - c1s); }
    asm volatile("s_waitcnt vmcnt(0)" : "+v"(xr[0]), "+v"(xr[1]) :: "memory");
    for (int c = 0; c < 32; ++c) {
        const size_t row0 = rowb + (size_t)c * 128;
        const int par = c & 1;
        LAS float* dtv = (LAS float*)(lds + T_DTV + par * 512); LAS float* csv = (LAS float*)(lds + T_CSV + par * 512); LAS float* gsv = (LAS float*)(lds + T_GSV + par * 512);
        if (w == 0) { dtv[lane] = d0; dtv[64 + lane] = d1; csv[lane] = c0s; csv[64 + lane] = c1s; gsv[lane] = g0s; gsv[64 + lane] = g1s; }
        const int bmo = T_BM + par * 32768;
        const size_t rown = (c + 1 < 32) ? row0 + 128 : row0;
        float dn0 = 0.f, dn1 = 0.f;
        if (w == 0) { dn0 = DT[(rown + lane) * 32 + h]; dn1 = DT[(rown + 64 + lane) * 32 + h]; }
        __syncthreads();
#pragma unroll
        for (int pt = 0; pt < 4; ++pt)
#pragma unroll
            for (int r = 0; r < 4; ++r) *(LAS unsigned short*)(lds + T_ST + (16 * pt + 4 * g4 + r) * 288 + (16 * w + fr) * 2) = f2bf(sacc[pt][r]);
        {
            const float cse = csv[127];
#pragma unroll
            for (int i = 0; i < 2; ++i) { const int s = xs0 + 64 * i; const float dts = dtv[s], wgt = __expf(cse - csv[s]);
                float xv[8]; unpack8(xr[i], xv);
#pragma unroll
                for (int e = 0; e < 8; ++e) xv[e] *= dts;
                u32x4 pk; pk.x = cvt_pk_bf16(xv[0], xv[1]); pk.y = cvt_pk_bf16(xv[2], xv[3]); pk.z = cvt_pk_bf16(xv[4], xv[5]); pk.w = cvt_pk_bf16(xv[6], xv[7]);
                *(LAS u32x4*)(lds + T_XD + s * T_XS + xc8 * 16) = pk;
#pragma unroll
                for (int e = 0; e < 8; ++e) xv[e] *= wgt;
                pk.x = cvt_pk_bf16(xv[0], xv[1]); pk.y = cvt_pk_bf16(xv[2], xv[3]); pk.z = cvt_pk_bf16(xv[4], xv[5]); pk.w = cvt_pk_bf16(xv[6], xv[7]);
                *(LAS u32x4*)(lds + T_XW + s * T_XS + xc8 * 16) = pk; }
        }
        __syncthreads();
        f32x4 yacc[4], oacc[4]; float el, skip; u32x2 zq[4], xq[4]; u32x4 xn[2];
        {
            bf16x8 cf[4];
#pragma unroll
            for (int ks = 0; ks < 4; ++ks) cf[ks] = SSD_FRAG(T_CM, w, ks);
            const float cl = csv[16 * w + fr];
            skip = Dh * __builtin_amdgcn_rcpf(fmaxf(dtv[16 * w + fr], 1e-30f));
#pragma unroll
            for (int pt = 0; pt < 4; ++pt) xq[pt] = *(const LAS u32x2*)(lds + T_XD + (16 * w + fr) * T_XS + (16 * pt + 4 * g4) * 2);
            asm volatile("s_waitcnt lgkmcnt(0)" : "+v"(cf[0]), "+v"(cf[1]), "+v"(cf[2]), "+v"(cf[3]) :: "memory");
            if (c + 1 < 32) { SSD_STAGE_B(rown, par ^ 1); SSD_STAGE_C(rown); }
            { const GAS char* xb = (const GAS char*)(XB + rown * 4096);
#pragma unroll
              for (int i = 0; i < 2; ++i) xn[i] = *(const GAS u32x4*)(xb + xoff + i * (64 * 8192)); }
            { const GAS char* zb = (const GAS char*)(proj + (row0 + 16 * w + fr) * NP + C_ZB + h * 64 + 4 * g4);
#pragma unroll
              for (int pt = 0; pt < 4; ++pt) zq[pt] = *(const GAS u32x2*)(zb + 32 * pt); }
#pragma unroll
            for (int pt = 0; pt < 4; ++pt) yacc[pt] = (f32x4){0.f, 0.f, 0.f, 0.f};
            for (int g0 = 0; g0 <= w; g0 += 4) {
                bf16x8 bfr[4][4]; f32x4 gv[4]; float ce[4]; s16x4 xa[2][4][2];
#pragma unroll
                for (int tt = 0; tt < 4; ++tt) { const int tcl = (g0 + tt <= w) ? g0 + tt : w;
#pragma unroll
                    for (int ks = 0; ks < 4; ++ks) bfr[tt][ks] = SSD_FRAG(bmo, tcl, ks);
                    gv[tt] = *(const LAS f32x4*)((tcl == w ? csv : gsv) + 16 * tcl + 4 * g4); ce[tt] = csv[16 * tcl + 15]; }
#pragma unroll
                for (int jj = 0; jj < 2; ++jj)
#pragma unroll
                    for (int pt = 0; pt < 4; ++pt) { const int s0 = 32 * ((g0 >> 1) + jj) + 4 * g4 + q;
                        xa[jj][pt][0] = vtr(lds + T_XD + s0 * T_XS + (16 * pt + 4 * pp) * 2);
                        xa[jj][pt][1] = vtr(lds + T_XD + (s0 + 16) * T_XS + (16 * pt + 4 * pp) * 2); }
                __builtin_amdgcn_sched_barrier(0);
                f32x4 acc[4];
#pragma unroll
                for (int tt = 0; tt < 4; ++tt) acc[tt] = (f32x4){0.f, 0.f, 0.f, 0.f};
#pragma unroll
                for (int ks = 0; ks < 4; ++ks)
#pragma unroll
                    for (int tt = 0; tt < 4; ++tt) acc[tt] = MFMA16(bfr[tt][ks], cf[ks], acc[tt]);
                s16x4 mh[4];
#pragma unroll
                for (int tt = 0; tt < 4; ++tt) { const int t = g0 + tt; float v[4];
                    if (t < w) { const float ft = __expf(cl - ce[tt]);
#pragma unroll
                        for (int r = 0; r < 4; ++r) v[r] = acc[tt][r] * (ft * gv[tt][r]);
                    } else if (t == w) {
#pragma unroll
                        for (int r = 0; r < 4; ++r) { const float e = __expf(fminf(cl - gv[tt][r], 0.f)); v[r] = (4 * g4 + r > fr) ? 0.f : acc[tt][r] * e; }
                    } else { v[0] = v[1] = v[2] = v[3] = 0.f; }
                    mh[tt] = pack4(v[0], v[1], v[2], v[3]); }
#pragma unroll
                for (int jj = 0; jj < 2; ++jj) { const bf16x8 mfrag = cat8(mh[2 * jj], mh[2 * jj + 1]);
#pragma unroll
                    for (int pt = 0; pt < 4; ++pt) yacc[pt] = MFMA16(cat8(xa[jj][pt][0], xa[jj][pt][1]), mfrag, yacc[pt]); }
            }
            bf16x8 sf[4][4];
#pragma unroll
            for (int ks = 0; ks < 4; ++ks)
#pragma unroll
                for (int pt = 0; pt < 4; ++pt) sf[ks][pt] = *(const LAS bf16x8*)(lds + T_ST + (16 * pt + fr) * 288 + (32 * ks + 8 * g4) * 2);
            __builtin_amdgcn_sched_barrier(0);
#pragma unroll
            for (int pt = 0; pt < 4; ++pt) oacc[pt] = (f32x4){0.f, 0.f, 0.f, 0.f};
#pragma unroll
            for (int ks = 0; ks < 4; ++ks)
#pragma unroll
                for (int pt = 0; pt < 4; ++pt) oacc[pt] = MFMA16(sf[ks][pt], cf[ks], oacc[pt]);
            el = __expf(cl);
        }
        {
            const float dtot = __expf(csv[127]);
#pragma unroll
            for (int pt = 0; pt < 4; ++pt) sacc[pt] *= dtot;
            const int ncol = 16 * w + 4 * pp;
#pragma unroll
            for (int kst = 0; kst < 4; ++kst) {
                const int r0 = 32 * kst + 4 * g4 + q;
                const bf16x8 bfrag = cat8(vtr(lds + bmo + (ncol >> 6) * 16384 + pg8::lds_byte(r0, ncol & 63)), vtr(lds + bmo + (ncol >> 6) * 16384 + pg8::lds_byte(r0 + 16, ncol & 63)));
#pragma unroll
                for (int pt = 0; pt < 4; ++pt)
                    sacc[pt] = MFMA16(cat8(vtr(lds + T_XW + r0 * T_XS + (16 * pt + 4 * pp) * 2), vtr(lds + T_XW + (r0 + 16) * T_XS + (16 * pt + 4 * pp) * 2)), bfrag, sacc[pt]);
            }
        }
        if (w == 0) { c0s = wave_incl_scan(dn0 * A_h, lane); c1s = wave_incl_scan(dn1 * A_h, lane) + __shfl(c0s, 63);
            g0s = __expf(__shfl(c0s, lane | 15) - c0s); g1s = __expf(__shfl(c1s, lane | 15) - c1s); }
        asm volatile("s_waitcnt lgkmcnt(0)" ::: "memory");
        __syncthreads();
        asm volatile("s_waitcnt vmcnt(0)" : "+v"(zq[0]), "+v"(zq[1]), "+v"(zq[2]), "+v"(zq[3]), "+v"(xn[0]), "+v"(xn[1]) :: "memory");
        { GAS char* yb = (GAS char*)(YG + row0 * DM) + (unsigned)((16 * w + fr) * DM + h * 64 + 4 * g4) * 2u;
#pragma unroll
          for (int pt = 0; pt < 4; ++pt) {
            const float xx[4] = {bf_lo(xq[pt].x), bf_hi(xq[pt].x), bf_lo(xq[pt].y), bf_hi(xq[pt].y)}, zz[4] = {bf_lo(zq[pt].x), bf_hi(zq[pt].x), bf_lo(zq[pt].y), bf_hi(zq[pt].y)};
            float yo[4];
#pragma unroll
            for (int r = 0; r < 4; ++r) { const float y = yacc[pt][r] + el * oacc[pt][r] + xx[r] * skip; yo[r] = y * silu_f(zz[r]); }
            u32x2 ow; ow.x = cvt_pk_bf16(yo[0], yo[1]); ow.y = cvt_pk_bf16(yo[2], yo[3]);
            *(GAS u32x2*)(yb + 32 * pt) = ow;
          } }
        xr[0] = xn[0]; xr[1] = xn[1]; d0 = dn0; d1 = dn1;
    }
    asm volatile("s_waitcnt vmcnt(0)" ::: "memory");
    GAS float* pssm = (GAS float*)(A.out + O_PSSM);
#pragma unroll
    for (int pt = 0; pt < 4; ++pt)
#pragma unroll
        for (int r = 0; r < 4; ++r) pssm[((size_t)(b * 32 + h) * 64 + 16 * pt + 4 * g4 + r) * 128 + 16 * w + fr] = sacc[pt][r];
#undef SSD_FRAG
#undef SSD_STAGE_B
#undef SSD_STAGE_C
}

__device__ __forceinline__ void ssd_decode_task(const Ctx& X, const Args& A, int task) {
    unsigned char* const wsl = fresh_ws(A);
    const int lane = X.lane, b = task >> 7, h = (task >> 2) & 31, pq = task & 3, gi = h >> 2;
    const int p = pq * 16 + (lane >> 2), nq = lane & 3;
    const GAS bf16_t* proj = (const GAS bf16_t*)(wsl + WS_PROJ); const GAS bf16_t* XB = (const GAS bf16_t*)(wsl + WS_XBCA); const GAS float* DT = (const GAS float*)(wsl + WS_DT); GAS bf16_t* YG = (GAS bf16_t*)(wsl + WS_YG);
    const float A_h = -expf(((const GAS float*)A.in[17])[h]), Dh = ((const GAS float*)A.in[18])[h];
    const GAS f32x4* sp = (const GAS f32x4*)((const GAS float*)A.in[6] + ((size_t)(b * 32 + h) * 64 + p) * 128 + nq * 32);
    LAS unsigned char* wl = X.lds + X.wave * 4096;
    u32x4 pc[4];
#pragma unroll
    for (int j = 0; j < 4; ++j) { const int piece = lane + 64 * j, t = piece >> 5, which = (piece >> 4) & 1, chunk = piece & 15;
        pc[j] = *(const GAS u32x4*)(XB + (size_t)(MP + b * 8 + t) * 4096 + 2048 + which * 1024 + gi * 128 + chunk * 8); }
    float dtv[8], xv[8], zv[8];
#pragma unroll
    for (int t = 0; t < 8; ++t) { const size_t row = (size_t)(MP + b * 8 + t);
        dtv[t] = DT[row * 32 + h]; xv[t] = bf2f(XB[row * 4096 + h * 64 + p]); zv[t] = bf2f(proj[row * NP + C_ZB + h * 64 + p]); }
    float st[32];
#pragma unroll
    for (int i = 0; i < 8; ++i) { const f32x4 v = sp[i]; st[4 * i] = v[0]; st[4 * i + 1] = v[1]; st[4 * i + 2] = v[2]; st[4 * i + 3] = v[3]; }
#pragma unroll
    for (int j = 0; j < 4; ++j) *(LAS u32x4*)(wl + (lane + 64 * j) * 16) = pc[j];
#pragma unroll
    for (int t = 0; t < 8; ++t) {
        const size_t row = (size_t)(MP + b * 8 + t);
        const float dt = dtv[t], dA = __expf(dt * A_h), xx = xv[t], xdt = xx * dt;
        float dot = 0.f;
#pragma unroll
        for (int i = 0; i < 4; ++i) { float bb[8], cv[8]; unpack8(*(const LAS u32x4*)(wl + (32 * t + nq * 4 + i) * 16), bb); unpack8(*(const LAS u32x4*)(wl + (32 * t + 16 + nq * 4 + i) * 16), cv);
#pragma unroll
            for (int e = 0; e < 8; ++e) { st[8 * i + e] = st[8 * i + e] * dA + xdt * bb[e]; dot += st[8 * i + e] * cv[e]; } }
        dot += __shfl_xor(dot, 1); dot += __shfl_xor(dot, 2);
        if (nq == 0) YG[row * DM + h * 64 + p] = f2bf((dot + xx * Dh) * silu_f(zv[t]));
    }
    GAS f32x4* op = (GAS f32x4*)(A.out + O_SSSM + ((size_t)(b * 32 + h) * 64 + p) * 128 + nq * 32);
#pragma unroll
    for (int i = 0; i < 8; ++i) op[i] = (f32x4){st[4 * i], st[4 * i + 1], st[4 * i + 2], st[4 * i + 3]};
}

constexpr int A_K = 0, A_V = 73728;
struct AttnItem { const GAS bf16_t* kc; const GAS bf16_t* vc; int m0; };
__device__ __forceinline__ AttnItem attn_item(const Args& A, int it) {
    const int g = it >> 10, rem = it & 1023, dsh = 2 * g, d = 1 << dsh, nqbsh = 5 - dsh;
    const int qb = rem & ((1 << nqbsh) - 1), rr = (rem >> nqbsh) & (d - 1), bh = rem >> (nqbsh + dsh), b = bh >> 3, h = bh & 7;
    const GAS bf16_t* kvc = (const GAS bf16_t*)(A.ws + WS_KVC);
    AttnItem N; N.m0 = 128 * qb - 144;
    N.kc = kvc + ((size_t)(((0 * 3 + g) * 4 + b) * 8 + h) << 19) + ((size_t)rr << (12 - dsh)) * 128;
    N.vc = kvc + ((size_t)(((1 * 3 + g) * 4 + b) * 8 + h) << 19) + ((size_t)rr << (12 - dsh)) * 128;
    return N;
}
__device__ __forceinline__ void attn_load_piece(const Ctx& X, const AttnItem& N, int i, u32x4& v, unsigned& zmask) {
    int idx = X.tid + 512 * i; if (idx >= (256 + 272) * 16) idx -= 4096;
    const int ch = idx & 15; int r = idx >> 4; const bool isv = r >= 256; if (isv) r -= 256;
    const int m = N.m0 + (isv ? r : r + 16);
    if (m < 0) zmask |= 1u << i;
    v = *(const GAS u32x4*)((isv ? N.vc : N.kc) + (m < 0 ? 0 : m) * 128 + ch * 8);
}
__device__ __forceinline__ unsigned attn_load(const Ctx& X, const Args& A, int it, u32x4 (&v)[17]) {
    const AttnItem N = attn_item(A, it);
    unsigned zmask = 0u;
#pragma unroll
    for (int i = 0; i < 17; ++i) attn_load_piece(X, N, i, v[i], zmask);
    return zmask;
}
__device__ __forceinline__ void attn_store(const Ctx& X, const u32x4 (&v)[17], unsigned zmask) {
#pragma unroll
    for (int i = 0; i < 17; ++i) {
        const int idx = X.tid + 512 * i, ch = idx & 15; int r = idx >> 4; const bool isv = r >= 256; if (isv) r -= 256;
        const u32x4 w = ((zmask >> i) & 1u) ? (u32x4){0u, 0u, 0u, 0u} : v[i];
        if (idx < (256 + 272) * 16) *(LAS u32x4*)(X.lds + (isv ? A_V : A_K) + r * 288 + ch * 16) = w;
    }
}
__device__ __forceinline__ void attn_load_q(const Ctx& X, const Args& A, int it, bf16x8 (&qf)[4]) {
    const int lane = X.lane, w = X.wave, fr = lane & 15, g4 = lane >> 4;
    const int g = it >> 10, rem = it & 1023, dsh = 2 * g, d = 1 << dsh, nqbsh = 5 - dsh;
    const int qb = rem & ((1 << nqbsh) - 1), rr = (rem >> nqbsh) & (d - 1), bh = rem >> (nqbsh + dsh), b = bh >> 3, h = bh & 7;
    const GAS bf16_t* proj = (const GAS bf16_t*)(A.ws + WS_PROJ);
    const long qrow = (long)b * 4096 + rr + (long)(128 * qb + 16 * w + fr) * d;
#pragma unroll
    for (int ks = 0; ks < 4; ++ks) qf[ks] = *(const GAS bf16x8*)(proj + qrow * NP + C_Q + g * 1024 + h * 128 + 32 * ks + 8 * g4);
}
__device__ __forceinline__ unsigned attn_prompt_compute(const Ctx& X, const Args& A, int it, const bf16x8 (&qf)[4], int nxt, bf16x8 (&qn)[4], u32x4 (&kv)[17], unsigned* ctr, unsigned& fut) {
    unsigned char* const wsl = fresh_ws(A);
    LAS unsigned char* lds = X.lds;
    const int lane = X.lane, w = X.wave, fr = lane & 15, g4 = lane >> 4;
    const int g = it >> 10, rem = it & 1023, dsh = 2 * g, d = 1 << dsh, nqbsh = 5 - dsh;
    const int qb = rem & ((1 << nqbsh) - 1), rr = (rem >> nqbsh) & (d - 1), bh = rem >> (nqbsh + dsh), b = bh >> 3, h = bh & 7;
    const GAS bf16_t* proj = (const GAS bf16_t*)(wsl + WS_PROJ);
    GAS bf16_t* OG = (GAS bf16_t*)(wsl + WS_OG) + (size_t)g * MT * 1024; GAS float* LSE = (GAS float*)(wsl + WS_LSE) + (size_t)g * MT * 8;
    const long rowb = (long)b * 4096 + rr;
    const int m0 = 128 * qb - 144;
    const int hc = g * 1024 + h * 128;
    const int mq = 128 * qb + 16 * w + fr;
    const long qrow = rowb + (long)mq * d;
    const AttnItem NI = attn_item(A, nxt); unsigned zmn = 0u;
    attn_load_q(X, A, nxt, qn);
    f32x4 sc[9];
#pragma unroll
    for (int kt = 1; kt <= 9; ++kt) {
        f32x4 acc = (f32x4){0.f, 0.f, 0.f, 0.f};
        const int krow = 16 * w + 16 * kt - 16 + fr;
#pragma unroll
        for (int ks = 0; ks < 4; ++ks) acc = MFMA16(*(const LAS bf16x8*)(lds + A_K + krow * 288 + (32 * ks + 8 * g4) * 2), qf[ks], acc);
        sc[kt - 1] = acc;
        attn_load_piece(X, NI, kt - 1, kv[kt - 1], zmn);
    }
    const float NEG = -__builtin_inff();
#pragma unroll
    for (int r = 0; r < 4; ++r) { if (4 * g4 + r < fr) sc[0][r] = NEG; if (4 * g4 + r > fr) sc[8][r] = NEG; }
    if (qb == 0) {
#pragma unroll
        for (int kt = 1; kt <= 9; ++kt)
#pragma unroll
            for (int r = 0; r < 4; ++r) if (m0 + 16 * w + 16 * kt + 4 * g4 + r < 0) sc[kt - 1][r] = NEG;
    }
    float mx = sc[0][0];
#pragma unroll
    for (int kt = 0; kt < 9; ++kt)
#pragma unroll
        for (int r = 0; r < 4; ++r) mx = fmaxf(mx, sc[kt][r]);
    mx = fmaxf(mx, __shfl_xor(mx, 16)); mx = fmaxf(mx, __shfl_xor(mx, 32));
    const float c2 = ATT_SCALE * 1.4426950408889634f;
    float l = 0.f;
#pragma unroll
    for (int kt = 0; kt < 9; ++kt)
#pragma unroll
        for (int r = 0; r < 4; ++r) { const float p = __builtin_amdgcn_exp2f((sc[kt][r] - mx) * c2); sc[kt][r] = p; l += p; }
    l += __shfl_xor(l, 16); l += __shfl_xor(l, 32);
    bf16x8 pf[5];
    pf[0] = cat8((s16x4){0, 0, 0, 0}, pack4(sc[0][0], sc[0][1], sc[0][2], sc[0][3]));
#pragma unroll
    for (int j = 1; j < 5; ++j) pf[j] = cat8(pack4(sc[2 * j - 1][0], sc[2 * j - 1][1], sc[2 * j - 1][2], sc[2 * j - 1][3]), pack4(sc[2 * j][0], sc[2 * j][1], sc[2 * j][2], sc[2 * j][3]));
    f32x4 oacc[8];
#pragma unroll
    for (int dt = 0; dt < 8; ++dt) oacc[dt] = (f32x4){0.f, 0.f, 0.f, 0.f};
    const int q = fr >> 2, pp = fr & 3;
#pragma unroll
    for (int j = 0; j < 5; ++j) {
        const int r0 = 16 * w + 32 * j + 4 * g4 + q;
        s16x4 a0[8], a1[8];
#pragma unroll
        for (int dt = 0; dt < 8; ++dt) { a0[dt] = vtr(lds + A_V + r0 * 288 + (16 * dt + 4 * pp) * 2); a1[dt] = vtr(lds + A_V + (r0 + 16) * 288 + (16 * dt + 4 * pp) * 2); }
        __builtin_amdgcn_sched_barrier(0);
#pragma unroll
        for (int dt = 0; dt < 8; ++dt) oacc[dt] = MFMA16(cat8(a0[dt], a1[dt]), pf[j], oacc[dt]);
        if (j < 4) { attn_load_piece(X, NI, 9 + 2 * j, kv[9 + 2 * j], zmn); attn_load_piece(X, NI, 10 + 2 * j, kv[10 + 2 * j], zmn); }
        if (j == 3 && X.tid == 0) asm volatile("global_atomic_add %0, %1, %2, %3 sc0" : "=v"(fut) : "v"(0u), "v"(1u), "s"(ctr) : "memory");
        __builtin_amdgcn_sched_barrier(0);
    }
    const float inv = 1.f / l;
#pragma unroll
    for (int dt = 0; dt < 8; ++dt) { u32x2 ow; ow.x = cvt_pk_bf16(oacc[dt][0] * inv, oacc[dt][1] * inv); ow.y = cvt_pk_bf16(oacc[dt][2] * inv, oacc[dt][3] * inv);
        *(GAS u32x2*)(OG + qrow * 1024 + h * 128 + 16 * dt + 4 * g4) = ow; }
    if (g4 == 0) LSE[qrow * 8 + h] = mx * ATT_SCALE + __logf(l);
    return zmn;
}

__device__ __forceinline__ void attn_decode_item(const Ctx& X, const Args& A, int it) {
    unsigned char* const wsl = fresh_ws(A);
    const int lane = X.lane, t = X.wave, hh = lane >> 5, l32 = lane & 31;
    const int g = it >> 8, b = (it >> 3) & 31, h = it & 7, wb = 128 << (2 * g), d = 1 << (2 * g);
    const GAS bf16_t* proj = (const GAS bf16_t*)(wsl + WS_PROJ);
    const GAS float* cache = (const GAS float*)A.in[2 + g];
    GAS bf16_t* OG = (GAS bf16_t*)(wsl + WS_OG) + (size_t)g * MT * 1024; GAS float* LSE = (GAS float*)(wsl + WS_LSE) + (size_t)g * MT * 8;
    const int hc = g * 1024 + h * 128 + 4 * l32;
    const size_t qrow = (size_t)(MP + b * 8 + t);
    const u32x2 qq = *(const GAS u32x2*)(proj + qrow * NP + C_Q + hc);
    const float q0 = bf_lo(qq.x) * ATT_SCALE, q1 = bf_hi(qq.x) * ATT_SCALE, q2 = bf_lo(qq.y) * ATT_SCALE, q3 = bf_hi(qq.y) * ATT_SCALE;
    float m = -1e30f, l = 0.f, o0 = 0.f, o1 = 0.f, o2 = 0.f, o3 = 0.f;
#define DEC_KEY(kk, vq, ok) do { float s_ = (q0 * (kk)[0] + q1 * (kk)[1]) + (q2 * (kk)[2] + q3 * (kk)[3]); \
        s_ += __shfl_xor(s_, 1); s_ += __shfl_xor(s_, 2); s_ += __shfl_xor(s_, 4); s_ += __shfl_xor(s_, 8); s_ += __shfl_xor(s_, 16); \
        if (ok) { const float mn_ = fmaxf(m, s_), al_ = __expf(m - mn_), p_ = __expf(s_ - mn_); \
            l = l * al_ + p_; o0 = o0 * al_ + p_ * (vq)[0]; o1 = o1 * al_ + p_ * (vq)[1]; o2 = o2 * al_ + p_ * (vq)[2]; o3 = o3 * al_ + p_ * (vq)[3]; m = mn_; } } while (0)
    const int jn = t / d + 1;
    { u32x2 k2[4], v2[4];
#pragma unroll
      for (int i = 0; i < 4; ++i) { const int j = 2 * i + hh, jc = j < jn ? j : 0; const size_t r = (size_t)(MP + b * 8 + (t - jc * d));
          k2[i] = *(const GAS u32x2*)(proj + r * NP + C_K + hc); v2[i] = *(const GAS u32x2*)(proj + r * NP + C_V + hc); }
#pragma unroll
      for (int i = 0; i < 4; ++i) { const int j = 2 * i + hh;
          const f32x4 kk = (f32x4){bf_lo(k2[i].x), bf_hi(k2[i].x), bf_lo(k2[i].y), bf_hi(k2[i].y)}, vq = (f32x4){bf_lo(v2[i].x), bf_hi(v2[i].x), bf_lo(v2[i].y), bf_hi(v2[i].y)};
          DEC_KEY(kk, vq, j < jn); } }
    const GAS float* cbase = cache + (size_t)b * wb * 2048 + h * 128 + 4 * l32;
    for (int i0 = 0; jn + 2 * i0 <= 128; i0 += 8) {
        f32x4 kv[8], vv[8];
#pragma unroll
        for (int u = 0; u < 8; ++u) {
            int j = jn + 2 * (i0 + u) + hh; if (j > 128) j = 128;
            const GAS float* p = cbase + (size_t)(wb + t - j * d) * 2048; kv[u] = *(const GAS f32x4*)p; vv[u] = *(const GAS f32x4*)(p + 1024);
        }
#pragma unroll
        for (int u = 0; u < 8; ++u) { const int j = jn + 2 * (i0 + u) + hh; DEC_KEY(kv[u], vv[u], j <= 128); }
    }
#undef DEC_KEY
    const float m2 = __shfl_xor(m, 32), mm = fmaxf(m, m2), a1 = __expf(m - mm);
    l *= a1; o0 *= a1; o1 *= a1; o2 *= a1; o3 *= a1;
    l += __shfl_xor(l, 32); o0 += __shfl_xor(o0, 32); o1 += __shfl_xor(o1, 32); o2 += __shfl_xor(o2, 32); o3 += __shfl_xor(o3, 32);
    const float inv = 1.f / l;
    if (hh == 0) { u32x2 ow; ow.x = cvt_pk_bf16(o0 * inv, o1 * inv); ow.y = cvt_pk_bf16(o2 * inv, o3 * inv); *(GAS u32x2*)(OG + qrow * 1024 + h * 128 + 4 * l32) = ow; }
    if (lane == 0) LSE[qrow * 8 + h] = mm + __logf(l);
}

__device__ __forceinline__ void cvt8_store(const GAS bf16_t* s, GAS float* dptr) {
    const u32x4 v = *(const GAS u32x4*)s;
    __builtin_nontemporal_store((f32x4){bf_lo(v.x), bf_hi(v.x), bf_lo(v.y), bf_hi(v.y)}, (GAS f32x4*)dptr);
    __builtin_nontemporal_store((f32x4){bf_lo(v.z), bf_hi(v.z), bf_lo(v.w), bf_hi(v.w)}, (GAS f32x4*)(dptr + 4));
}
__device__ __forceinline__ void extract_outputs(const Ctx& X, const Args& A) {
    unsigned char* const wsl = fresh_ws(A);
    const GAS bf16_t* proj = (const GAS bf16_t*)(wsl + WS_PROJ); const GAS bf16_t* kvc = (const GAS bf16_t*)(wsl + WS_KVC);
    const size_t gt = (size_t)X.bid * 512 + X.tid, GT = (size_t)X.G * 512;
#pragma unroll
    for (int g = 0; g < 3; ++g) {
        const int W = 128 << (2 * g);
        GAS float* po = (GAS float*)(A.out + (g == 0 ? O_PKV128 : g == 1 ? O_PKV512 : O_PKV2048));
        const size_t tot = (size_t)4 * W * 2 * 128;
        const int U = g == 0 ? 1 : (g == 1 ? 4 : 8);
        for (size_t i0 = gt; i0 < tot; i0 += GT * U) {
            u32x4 v[8];
#pragma unroll
            for (int q = 0; q < U; ++q) { size_t i = i0 + (size_t)q * GT; if (i >= tot) i = gt;
                const int u = (int)(i & 127), kv = (int)((i >> 7) & 1); const size_t bj = i >> 8; const int j = (int)(bj % W), b = (int)(bj / W);
                const int t = 4096 - W + j, ridx = ((t & ((1 << (2 * g)) - 1)) << (12 - 2 * g)) + (t >> (2 * g));
                v[q] = *(const GAS u32x4*)(kvc + ((size_t)((((kv * 3 + g) * 4 + b) * 8) + (u >> 4)) << 19) + (size_t)ridx * 128 + (u & 15) * 8); }
#pragma unroll
            for (int q = 0; q < U; ++q) { const size_t i = i0 + (size_t)q * GT;
                if (i < tot) { GAS float* dptr = po + i * 8;
                    __builtin_nontemporal_store((f32x4){bf_lo(v[q].x), bf_hi(v[q].x), bf_lo(v[q].y), bf_hi(v[q].y)}, (GAS f32x4*)dptr);
                    __builtin_nontemporal_store((f32x4){bf_lo(v[q].z), bf_hi(v[q].z), bf_lo(v[q].w), bf_hi(v[q].w)}, (GAS f32x4*)(dptr + 4)); } }
        }
        GAS float* so = (GAS float*)(A.out + (g == 0 ? O_SKV128 : g == 1 ? O_SKV512 : O_SKV2048));
        const size_t tot2 = (size_t)32 * 8 * 2 * 128;
        for (size_t i = gt; i < tot2; i += GT) { const int u = (int)(i & 127), kv = (int)((i >> 7) & 1); const int t = (int)((i >> 8) & 7), b = (int)(i >> 11);
            cvt8_store(proj + ((size_t)MP + b * 8 + t) * NP + (kv ? C_V : C_K) + g * 1024 + u * 8, so + (((size_t)b * W + (W - 8 + t)) * 2 + kv) * 1024 + u * 8); }
    }
    GAS float* pc = (GAS float*)(A.out + O_PCONV); GAS float* scv = (GAS float*)(A.out + O_SCONV);
    for (size_t i = gt; i < (size_t)4 * 3 * 512; i += GT) { const int u = (int)(i & 511), j = (int)((i >> 9) % 3), b = (int)(i / 1536);
        cvt8_store(proj + ((size_t)b * 4096 + 4093 + j) * NP + C_XBC + u * 8, pc + i * 8); }
    for (size_t i = gt; i < (size_t)32 * 3 * 512; i += GT) { const int u = (int)(i & 511), j = (int)((i >> 9) % 3), b = (int)(i / 1536);
        cvt8_store(proj + ((size_t)MP + b * 8 + 5 + j) * NP + C_XBC + u * 8, scv + i * 8); }
}

__device__ __forceinline__ void phase3(const Ctx& X, const Args& A) {
    conv_prepass(X, A);
    for (int it = X.bid; it < 768 * REP_DEC; it += X.G) attn_decode_item(X, A, it % 768);
    extract_outputs(X, A);
#if REP_DEC > 1
    extract_outputs(X, A);
#endif
}
constexpr int CW_QATT = 8192;
__device__ __forceinline__ int att_next(const Ctx& X, const Args& A) {
    volatile LAS unsigned* MISC = (volatile LAS unsigned*)(X.lds + MISC_OFF);
    if (X.tid == 0) MISC[16] = __hip_atomic_fetch_add((unsigned*)(A.ws + WS_CTL) + CW_QATT, 1u, __ATOMIC_RELAXED, __HIP_MEMORY_SCOPE_AGENT);
    __syncthreads();
    const int v = (int)MISC[16];
    __syncthreads();
    return v;
}
__device__ __forceinline__ void phase3b(const Ctx& X, const Args& A) {
    for (int it = X.bid; it < 128 * REP_SSD; it += X.G) { const int i = it & 127, xcd = i & 7, slot = i >> 3, grp = xcd * 4 + (slot >> 2);
        ssd_prompt_item64(X, A, grp >> 3, (grp & 7) * 4 + (slot & 3)); }
    {
        constexpr int NATT = 3072 * REP_ATT;
        volatile LAS unsigned* MISC = (volatile LAS unsigned*)(X.lds + MISC_OFF);
        unsigned* const ctr = (unsigned*)(A.ws + WS_CTL) + CW_QATT;
        u32x4 kv[17]; unsigned zm = 0u, fut = 0u;
        if (X.tid == 0) MISC[16] = __hip_atomic_fetch_add(ctr, 2u, __ATOMIC_RELAXED, __HIP_MEMORY_SCOPE_AGENT);
        __syncthreads();
        int it = (int)MISC[16], nx = it + 1;
        if (X.tid == 0) asm volatile("global_atomic_add %0, %1, %2, %3 sc0" : "=v"(fut) : "v"(0u), "v"(1u), "s"(ctr) : "memory");
        bf16x8 qf[4];
        if (it < NATT) { attn_load_q(X, A, it % 3072, qf); zm = attn_load(X, A, it % 3072, kv); }
        while (it < NATT) {
            attn_store(X, kv, zm);
            if (X.tid == 0) { asm volatile("s_waitcnt vmcnt(0)" : "+v"(fut) :: "memory"); MISC[16] = fut; }
            const int pn = (nx < NATT ? nx : it) % 3072;
            bf16x8 qn[4];
            __syncthreads();
            zm = attn_prompt_compute(X, A, it % 3072, qf, pn, qn, kv, ctr, fut);
#pragma unroll
            for (int ks = 0; ks < 4; ++ks) qf[ks] = qn[ks];
            __syncthreads();
            it = nx; nx = (int)MISC[16];
        }
        if (X.tid == 0) asm volatile("s_waitcnt vmcnt(0)" : "+v"(fut) :: "memory");
    }
    for (int task = X.bid * 8 + X.wave; task < 4096 * REP_DEC; task += X.G * 8) ssd_decode_task(X, A, task & 4095);
}

__device__ __forceinline__ void phase4(const Ctx& X, const Args& A) {
    unsigned char* const wsl = fresh_ws(A);
    const GAS bf16_t* proj = (const GAS bf16_t*)(wsl + WS_PROJ); const GAS bf16_t* OG = (const GAS bf16_t*)(wsl + WS_OG); const GAS float* LSE = (const GAS float*)(wsl + WS_LSE);
    const GAS bf16_t* YG = (const GAS bf16_t*)(wsl + WS_YG); GAS bf16_t* AY = (GAS bf16_t*)(wsl + WS_AY); const GAS float* gssm = (const GAS float*)A.in[19];
    const int gw = X.bid * 8 + X.wave, NGW = X.G * 8, lane = X.lane;
    f32x4 gsv[8];
    { const GAS f32x4* gp = (const GAS f32x4*)(gssm + 32 * lane);
#pragma unroll
      for (int q = 0; q < 8; ++q) gsv[q] = gp[q]; }
    for (int m = gw; m < MT; m += NGW) {
        u32x4 yv[4], zv[2];
        { const GAS u32x4* zp = (const GAS u32x4*)(proj + (size_t)m * NP + C_ZA + 16 * lane); zv[0] = zp[0]; zv[1] = zp[1]; }
        { const GAS u32x4* yp = (const GAS u32x4*)(YG + (size_t)m * DM + 32 * lane);
#pragma unroll
          for (int q = 0; q < 4; ++q) yv[q] = yp[q]; }
        __builtin_amdgcn_sched_barrier(0);
        {
            const int hd = lane >> 3;
            const float l0 = LSE[(size_t)m * 8 + hd], l1 = LSE[((size_t)MT + m) * 8 + hd], l2 = LSE[((size_t)2 * MT + m) * 8 + hd];
            const float mx = fmaxf(l0, fmaxf(l1, l2)); float w0 = __expf(l0 - mx), w1 = __expf(l1 - mx), w2 = __expf(l2 - mx); const float inv = 1.f / (w0 + w1 + w2); w0 *= inv; w1 *= inv; w2 *= inv;
            float o[16];
#pragma unroll
            for (int e = 0; e < 16; ++e) o[e] = 0.f;
#pragma unroll
            for (int g = 0; g < 3; ++g) { const float wg = g == 0 ? w0 : (g == 1 ? w1 : w2);
                const GAS u32x4* p = (const GAS u32x4*)(OG + ((size_t)g * MT + m) * 1024 + 16 * lane);
#pragma unroll
                for (int q = 0; q < 2; ++q) { const u32x4 v = p[q];
                    o[8 * q + 0] += wg * bf_lo(v.x); o[8 * q + 1] += wg * bf_hi(v.x); o[8 * q + 2] += wg * bf_lo(v.y); o[8 * q + 3] += wg * bf_hi(v.y);
                    o[8 * q + 4] += wg * bf_lo(v.z); o[8 * q + 5] += wg * bf_hi(v.z); o[8 * q + 6] += wg * bf_lo(v.w); o[8 * q + 7] += wg * bf_hi(v.w); } }
            GAS u32x4* op = (GAS u32x4*)(AY + (size_t)m * KAB + 16 * lane);
#pragma unroll
            for (int q = 0; q < 2; ++q) { const u32x4 z = zv[q]; u32x4 w;
                w.x = cvt_pk_bf16(o[8 * q + 0] * silu_f(bf_lo(z.x)), o[8 * q + 1] * silu_f(bf_hi(z.x))); w.y = cvt_pk_bf16(o[8 * q + 2] * silu_f(bf_lo(z.y)), o[8 * q + 3] * silu_f(bf_hi(z.y)));
                w.z = cvt_pk_bf16(o[8 * q + 4] * silu_f(bf_lo(z.z)), o[8 * q + 5] * silu_f(bf_hi(z.z))); w.w = cvt_pk_bf16(o[8 * q + 6] * silu_f(bf_lo(z.w)), o[8 * q + 7] * silu_f(bf_hi(z.w)));
                op[q] = w; }
        }
        {
            float y[32]; float ss = 0.f;
#pragma unroll
            for (int q = 0; q < 4; ++q) { const u32x4 v = yv[q];
                y[8 * q + 0] = bf_lo(v.x); y[8 * q + 1] = bf_hi(v.x); y[8 * q + 2] = bf_lo(v.y); y[8 * q + 3] = bf_hi(v.y); y[8 * q + 4] = bf_lo(v.z); y[8 * q + 5] = bf_hi(v.z); y[8 * q + 6] = bf_lo(v.w); y[8 * q + 7] = bf_hi(v.w); }
#pragma unroll
            for (int e = 0; e < 32; ++e) ss += y[e] * y[e];
            ss += __shfl_xor(ss, 1); ss += __shfl_xor(ss, 2); ss += __shfl_xor(ss, 4);
            const float rs = rsqrtf(ss * (1.f / 256.f) + NORM_EPS);
            GAS u32x4* op = (GAS u32x4*)(AY + (size_t)m * KAB + 1024 + 32 * lane);
#pragma unroll
            for (int q = 0; q < 4; ++q) { const f32x4 ga = gsv[2 * q], gb = gsv[2 * q + 1]; u32x4 w;
                w.x = cvt_pk_bf16(y[8 * q + 0] * rs * ga[0], y[8 * q + 1] * rs * ga[1]); w.y = cvt_pk_bf16(y[8 * q + 2] * rs * ga[2], y[8 * q + 3] * rs * ga[3]);
                w.z = cvt_pk_bf16(y[8 * q + 4] * rs * gb[0], y[8 * q + 5] * rs * gb[1]); w.w = cvt_pk_bf16(y[8 * q + 6] * rs * gb[2], y[8 * q + 7] * rs * gb[3]);
                op[q] = w; }
        }
    }
}

template <int KSTEPS> __device__ __forceinline__ f32x4 skinny_acc(const GAS bf16_t* arow, const GAS bf16_t* brow) {
    f32x4 acc = (f32x4){0.f, 0.f, 0.f, 0.f};
#pragma unroll
    for (int k0 = 0; k0 < KSTEPS; k0 += 16) {
        bf16x8 a[16], b[16];
#pragma unroll
        for (int u = 0; u < 16; ++u) { a[u] = *(const GAS bf16x8*)(arow + (k0 + u) * 32); b[u] = *(const GAS bf16x8*)(brow + (k0 + u) * 32); }
        __builtin_amdgcn_sched_barrier(0);
#pragma unroll
        for (int u = 0; u < 16; ++u) acc = MFMA16(a[u], b[u], acc);
        __builtin_amdgcn_sched_barrier(0);
    }
    return acc;
}
__device__ __forceinline__ void decode_merge(GAS unsigned char* wsg, int bid, int G) {
    const GAS bf16_t* AY = (const GAS bf16_t*)(wsg + WS_AY); const GAS bf16_t* WAB = (const GAS bf16_t*)(wsg + WS_WAB); const GAS bf16_t* proj = (const GAS bf16_t*)(wsg + WS_PROJ); GAS bf16_t* MRG = (GAS bf16_t*)(wsg + WS_MRG);
    const int lane = threadIdx.x & 63, wave = threadIdx.x >> 6, fr = lane & 15, g4 = lane >> 4;
    for (int it = bid; it < 256; it += G) {
        const int c0 = (it & 31) * 64 + (wave & 3) * 16, r0 = MP + (it >> 5) * 32 + (wave >> 2) * 16;
        const GAS bf16_t* ar = AY + (size_t)(r0 + fr) * KAB + 8 * g4; const GAS bf16_t* br = WAB + (size_t)(c0 + fr) * KAB + 8 * g4;
        const f32x4 pa = skinny_acc<32>(ar, br), pb = skinny_acc<64>(ar + 1024, br + 1024);
#pragma unroll
        for (int r = 0; r < 4; ++r) { const size_t row = (size_t)(r0 + 4 * g4 + r); const int col = c0 + fr;
            const float ga = sigmoid_f(bf2f(proj[row * NP + C_RA + col])), gb = sigmoid_f(bf2f(proj[row * NP + C_RB + col]));
            MRG[row * DM + col] = f2bf(ga * pa[r] + gb * pb[r]); }
    }
}
__device__ __forceinline__ void decode_out(GAS unsigned char* wsg, int bid, int G) {
    const GAS bf16_t* MRG = (const GAS bf16_t*)(wsg + WS_MRG); const GAS bf16_t* WO = (const GAS bf16_t*)(wsg + WS_WO); GAS float* OUT = (GAS float*)(wsg + WS_OUTD);
    const int lane = threadIdx.x & 63, wave = threadIdx.x >> 6, fr = lane & 15, g4 = lane >> 4;
    for (int it = bid; it < 256; it += G) {
        const int c0 = (it & 31) * 64 + (wave & 3) * 16, r0 = MP + (it >> 5) * 32 + (wave >> 2) * 16;
        const f32x4 acc = skinny_acc<64>(MRG + (size_t)(r0 + fr) * DM + 8 * g4, WO + (size_t)(c0 + fr) * DM + 8 * g4);
#pragma unroll
        for (int r = 0; r < 4; ++r) OUT[(size_t)(r0 - MP + 4 * g4 + r) * DM + c0 + fr] = acc[r];
    }
}

template <bool BF> __device__ __forceinline__ void final_row(const GAS void* orow_, const GAS f32x4* xr, const GAS f32x4* gt4, const GAS f32x4* g4, GAS f32x4* o, int lane) {
    f32x4 v[8], xv[8]; float ss = 0.f;
#pragma unroll
    for (int j = 0; j < 8; ++j) xv[j] = __builtin_nontemporal_load(xr + lane + 64 * j);
    f32x4 ggv[8], gtv[8];
#pragma unroll
    for (int j = 0; j < 8; ++j) { ggv[j] = g4[lane + 64 * j]; gtv[j] = gt4[lane + 64 * j]; }
#pragma unroll
    for (int j = 0; j < 8; ++j) {
        if constexpr (BF) { const u32x2 q = __builtin_nontemporal_load((const GAS u32x2*)orow_ + lane + 64 * j); v[j] = (f32x4){bf_lo(q.x), bf_hi(q.x), bf_lo(q.y), bf_hi(q.y)}; }
        else v[j] = ((const GAS f32x4*)orow_)[lane + 64 * j]; }
    __builtin_amdgcn_sched_barrier(0);
#pragma unroll
    for (int j = 0; j < 8; ++j) {
        ss += (v[j][0] * v[j][0] + v[j][1] * v[j][1]) + (v[j][2] * v[j][2] + v[j][3] * v[j][3]); }
    const float rstd = rsqrtf(wave_sum(ss) * (1.f / DM) + NORM_EPS);
#pragma unroll
    for (int j = 0; j < 8; ++j) { const f32x4 gg = ggv[j], gt = gtv[j], xx = xv[j];
        f32x4 y;
#pragma unroll
        for (int e = 0; e < 4; ++e) y[e] = xx[e] + gt[e] * (v[j][e] * rstd * gg[e]);
        __builtin_nontemporal_store(y, o + lane + 64 * j); }
}
__device__ __forceinline__ void phase7(const Ctx& X, const Args& A) {
    unsigned char* const wsl = fresh_ws(A);
    const GAS float* xp = (const GAS float*)A.in[0]; const GAS float* xs = (const GAS float*)A.in[1]; const GAS f32x4* g4 = (const GAS f32x4*)A.in[12];
    const GAS float* mod = (const GAS float*)(wsl + WS_MOD); const GAS bf16_t* OUT = (const GAS bf16_t*)(wsl + WS_OUT); const GAS float* OUTD = (const GAS float*)(wsl + WS_OUTD);
    const int gw = X.bid * 8 + X.wave, NGW = X.G * 8, lane = X.lane;
    for (int m = gw; m < MP; m += NGW)
        final_row<true>(OUT + (size_t)m * DM, (const GAS f32x4*)(xp + (size_t)m * DM), (const GAS f32x4*)(mod + (m >> 12) * 6144 + 4096), g4, (GAS f32x4*)(A.out + (size_t)m * DM), lane);
    for (int m = gw; m < MD; m += NGW)
        final_row<false>(OUTD + (size_t)m * DM, (const GAS f32x4*)(xs + (size_t)m * DM), (const GAS f32x4*)(mod + (4 + (m >> 3)) * 6144 + 4096), g4, (GAS f32x4*)(A.out + (size_t)(MP + m) * DM), lane);
}

constexpr int NPHASES = 8;
__global__ void __launch_bounds__(512, 2) hyb_fwd(Args args) {
    extern __shared__ __attribute__((aligned(16))) unsigned char lds_raw[];
    Ctx X;
    X.lds = (LAS unsigned char*)lds_raw;
    X.tid = threadIdx.x; X.lane = X.tid & 63; X.wave = __builtin_amdgcn_readfirstlane(X.tid >> 6); X.bid = blockIdx.x; X.G = gridDim.x;
    volatile LAS unsigned* MISC = (volatile LAS unsigned*)(X.lds + MISC_OFF);
    if (X.tid < 64) MISC[X.tid] = 0u;
    __syncthreads();
    unsigned* ctl = (unsigned*)(args.ws + WS_CTL);
    XcdBarrier bar; bar.bar = ctl + CW_BAR; bar.x = 0; bar.st = nullptr;
    if (MK_N_LAUNCHES == 1) bar = xcd_barrier_post(ctl + CW_BAR, MISC + 8);
#define GRID_BAR() do { if (MK_N_LAUNCHES == 1) xcd_barrier(bar); } while (0)
    const int lo = args.ph_lo, hi = args.ph_hi;
#define IN(k) (lo <= (k) && (k) < hi)
#define BOTH(k) (IN(k) && IN((k) + 1))
#define FRESH_WS() unsigned char* ws = fresh_ws(args); (void)ws
#define DO_P0() do { phase0(X, args); if (BOTH(0)) GRID_BAR(); } while (0)
#define DO_P1() do { phase1(X, args); if (BOTH(1)) GRID_BAR(); } while (0)
#define DO_P2() do { FRESH_WS(); \
        pg8::Gemm g{(const GAS bf16_t*)(ws + WS_H), (const GAS bf16_t*)(ws + WS_WIN), MT, NP, DM, DM, DM}; pg8::StaticOrder S; S.init(MT, NP, X.G, X.bid, REP_P2); \
        pg8::EpiProj E{(GAS bf16_t*)(ws + WS_PROJ), NP, (GAS float*)(ws + WS_DT), (GAS bf16_t*)(ws + WS_KVC)}; \
        pg8::SideKvCopy side; side.init((GAS f32x4*)(ws + WS_DUMMY), args.in[2], args.in[3], args.in[4], args.out); \
        pg8::gemm_phase<pg8::EpiProj, pg8::StaticOrder, true, true, pg8::SideKvCopy>(X.lds, g, S, E, side); \
        { constexpr int kShort = (65 * 81) % 256; if (X.G == 256) { if (X.bid >= kShort) late_weight_transposes(X, args, kShort); } else late_weight_transposes(X, args, 0); } \
        if (BOTH(2)) GRID_BAR(); } while (0)
#define DO_P4() do { phase4(X, args); if (BOTH(4)) GRID_BAR(); } while (0)
#define DO_P5() do { FRESH_WS(); \
        pg8::StaticOrder S; S.init(MP, DM, X.G, X.bid, REP_P56); \
        { pg8::Gemm g{(const GAS bf16_t*)(ws + WS_AY), (const GAS bf16_t*)(ws + WS_WAB), MP, DM, 1024, KAB, KAB}; \
          pg8::EpiGateA E{(const GAS bf16_t*)(ws + WS_PROJ) + C_RA, NP, (GAS bf16_t*)(ws + WS_TMP)}; \
          pg8::gemm_phase<pg8::EpiGateA, pg8::StaticOrder, true, true>(X.lds, g, S, E); } \
        { pg8::Gemm g{(const GAS bf16_t*)(ws + WS_AY) + 1024, (const GAS bf16_t*)(ws + WS_WAB) + 1024, MP, DM, 2048, KAB, KAB}; \
          pg8::EpiGateB E{(const GAS bf16_t*)(ws + WS_PROJ) + C_RB, NP, (const GAS bf16_t*)(ws + WS_TMP), (GAS bf16_t*)(ws + WS_MRG)}; \
          pg8::gemm_phase<pg8::EpiGateB, pg8::StaticOrder, true, true>(X.lds, g, S, E); } \
        decode_merge((GAS unsigned char*)ws, X.bid, X.G); \
        if (BOTH(5)) GRID_BAR(); } while (0)
#define DO_P6() do { FRESH_WS(); \
        pg8::Gemm g{(const GAS bf16_t*)(ws + WS_MRG), (const GAS bf16_t*)(ws + WS_WO), MP, DM, DM, DM, DM}; pg8::StaticOrder S; S.init(MP, DM, X.G, X.bid, REP_P56); \
        pg8::EpiOutBf16 E{(GAS bf16_t*)(ws + WS_OUT), DM}; \
        pg8::gemm_phase<pg8::EpiOutBf16, pg8::StaticOrder, true, true>(X.lds, g, S, E); \
        decode_out((GAS unsigned char*)ws, X.bid, X.G); \
        if (BOTH(6)) GRID_BAR(); } while (0)
    if (IN(0)) { DO_P0();
#if REP_P0 > 1
        DO_P0();
#endif
    }
    if (IN(1)) { DO_P1();
#if REP_LIGHT > 1
        DO_P1();
#endif
    }
    if (IN(2)) { DO_P2(); }
    if (IN(3)) { phase3(X, args); GRID_BAR(); phase3b(X, args); if (BOTH(3)) GRID_BAR(); }
    if (IN(4)) { DO_P4();
#if REP_LIGHT > 1
        DO_P4();
#endif
    }
    if (IN(5)) { DO_P5(); }
    if (IN(6)) { DO_P6(); }
    if (IN(7)) { phase7(X, args);
#if REP_LIGHT > 1
        GRID_BAR(); phase7(X, args);
#endif
    }
#undef IN
#undef BOTH
#undef GRID_BAR
}

extern "C" void kernel_launch(void* const* d_in, const int* in_sizes, int n_in, void* d_out, int out_size, void* d_ws, size_t ws_size, hipStream_t stream) {
    static int grid = 0;
    if (grid == 0) {
        if (n_in != 23 || (size_t)out_size != O_END || ws_size < WS_END) { fprintf(stderr, "kernel_launch: unexpected shapes: n_in %d out %d ws %zu\n", n_in, out_size, ws_size); grid = -1; return; }
        int dev = 0, cus = 0, per_cu = 0;
        if (hipGetDevice(&dev) != hipSuccess || hipDeviceGetAttribute(&cus, hipDeviceAttributeMultiprocessorCount, dev) != hipSuccess) { grid = -1; return; }
        if (hipFuncSetAttribute((const void*)hyb_fwd, hipFuncAttributeMaxDynamicSharedMemorySize, LDS_BYTES) != hipSuccess) { fprintf(stderr, "kernel_launch: hipFuncSetAttribute failed\n"); grid = -1; return; }
        if (hipOccupancyMaxActiveBlocksPerMultiprocessor(&per_cu, (const void*)hyb_fwd, 512, LDS_BYTES) != hipSuccess || per_cu < 1) fprintf(stderr, "kernel_launch: occupancy query reports %d\n", per_cu);
        (void)hipGetLastError();
        grid = cus;
    }
    if (grid < 0) return;
    (void)in_sizes;
    if (hipMemsetAsync((char*)d_ws + WS_CTL, 0, CTL_ZERO_BYTES, stream) != hipSuccess) return;
    Args a{};
    for (int i = 0; i < 23; ++i) a.in[i] = d_in[i];
    a.out = (float*)d_out; a.ws = (unsigned char*)d_ws;
    if (MK_N_LAUNCHES == 1) { a.ph_lo = 0; a.ph_hi = NPHASES; hipLaunchKernelGGL(hyb_fwd, dim3(grid), dim3(512), LDS_BYTES, stream, a); }
    else for (int p = 0; p < NPHASES; ++p) { a.ph_lo = p; a.ph_hi = p + 1; hipLaunchKernelGGL(hyb_fwd, dim3(grid), dim3(512), LDS_BYTES, stream, a); }
}
```

```cpp
#include <hip/hip_runtime.h>
#include <cstdio>
#include <cstdint>

#ifndef MK_N_LAUNCHES
#define MK_N_LAUNCHES 1
#endif

#ifndef REP_P0
#define REP_P0 1
#endif
#ifndef REP_P2
#define REP_P2 1
#endif
#ifndef REP_SSD
#define REP_SSD 1
#endif
#ifndef REP_ATT
#define REP_ATT 1
#endif
#ifndef REP_DEC
#define REP_DEC 1
#endif
#ifndef REP_P56
#define REP_P56 1
#endif
#ifndef REP_LIGHT
#define REP_LIGHT 1
#endif

#define GAS __attribute__((address_space(1)))
#define LAS __attribute__((address_space(3)))
typedef unsigned short bf16_t;
typedef short bf16x8 __attribute__((ext_vector_type(8)));
typedef short s16x4 __attribute__((ext_vector_type(4)));
typedef float f32x4 __attribute__((ext_vector_type(4)));
typedef float f32x2 __attribute__((ext_vector_type(2)));
typedef unsigned u32x4 __attribute__((ext_vector_type(4)));
typedef unsigned u32x2 __attribute__((ext_vector_type(2)));

constexpr int DM = 2048, MP = 16384, MD = 256, MT = MP + MD;
constexpr int NP = 20736;
constexpr int NIN = 20512;
constexpr int C_Q = 0, C_K = 3072, C_V = 6144, C_ZA = 9216, C_ZB = 10240, C_XBC = 12288, C_RA = 16384, C_RB = 18432, C_DT = 20480;
constexpr int KAB = 3072;
constexpr float ATT_SCALE = 0.08838834764831845f;
constexpr float NORM_EPS = 1e-6f;

constexpr size_t O_YP = 0, O_YS = 33554432, O_PKV128 = O_YS + 524288, O_PKV512 = O_PKV128 + 1048576, O_PKV2048 = O_PKV512 + 4194304,
                 O_PCONV = O_PKV2048 + 16777216, O_PSSM = O_PCONV + 49152, O_SKV128 = O_PSSM + 1048576, O_SKV512 = O_SKV128 + 8388608,
                 O_SKV2048 = O_SKV512 + 33554432, O_SCONV = O_SKV2048 + 134217728, O_SSSM = O_SCONV + 393216, O_END = O_SSSM + 8388608;

constexpr size_t MiB = 1u << 20;
constexpr size_t WS_CTL = 0, CTL_ZERO_BYTES = 1 * MiB;
constexpr size_t WS_MOD = 1 * MiB;
constexpr size_t WS_WIN = 2 * MiB;
constexpr size_t WS_WAB = 83 * MiB;
constexpr size_t WS_WO = 95 * MiB;
constexpr size_t WS_H = 103 * MiB;
constexpr size_t WS_DT = 168 * MiB;
constexpr size_t WS_LSE = 171 * MiB;
constexpr size_t WS_PROJ = 173 * MiB;
constexpr size_t WS_OG = 832 * MiB;
constexpr size_t WS_YG = 930 * MiB;
constexpr size_t WS_AY = 995 * MiB;
constexpr size_t WS_TMP = 1093 * MiB;
constexpr size_t WS_XBCA = WS_TMP;
constexpr size_t WS_MRG = 1223 * MiB;
constexpr size_t WS_KVC = WS_MRG;
constexpr size_t WS_OUT = 1288 * MiB;
constexpr size_t WS_OUTD = 1420 * MiB;
constexpr size_t WS_DUMMY = 1418 * MiB;
constexpr size_t WS_END = 1423 * MiB;
constexpr int CW_BAR = 4096;

constexpr int LDS_BYTES = 163840;
constexpr int MISC_OFF = 163584;

__device__ __forceinline__ unsigned cvt_pk_bf16(float lo, float hi) { unsigned r; asm volatile("v_cvt_pk_bf16_f32 %0, %1, %2" : "=v"(r) : "v"(lo), "v"(hi)); return r; }
__device__ __forceinline__ float bf_lo(unsigned w) { return __uint_as_float(w << 16); }
__device__ __forceinline__ float bf_hi(unsigned w) { return __uint_as_float(w & 0xffff0000u); }
__device__ __forceinline__ float bf2f(unsigned short b) { return __uint_as_float(((unsigned)b) << 16); }
__device__ __forceinline__ unsigned short f2bf(float f) { return (unsigned short)(cvt_pk_bf16(f, 0.f) & 0xffffu); }
__device__ __forceinline__ s16x4 pack4(float a, float b, float c, float d) { u32x2 w; w.x = cvt_pk_bf16(a, b); w.y = cvt_pk_bf16(c, d); return __builtin_bit_cast(s16x4, w); }
__device__ __forceinline__ bf16x8 cat8(s16x4 lo, s16x4 hi) { return __builtin_shufflevector(lo, hi, 0, 1, 2, 3, 4, 5, 6, 7); }
__device__ __forceinline__ float silu_f(float x) { return x * __builtin_amdgcn_rcpf(1.f + __expf(-x)); }
__device__ __forceinline__ float sigmoid_f(float x) { return __builtin_amdgcn_rcpf(1.f + __expf(-x)); }
__device__ __forceinline__ float softplus_f(float x) { return x > 20.f ? x : log1pf(expf(x)); }
__device__ __forceinline__ float wave_sum(float v) {
#pragma unroll
    for (int o = 1; o < 64; o <<= 1) v += __shfl_xor(v, o);
    return v;
}
typedef short v4i16_t __attribute__((ext_vector_type(4)));
__device__ __forceinline__ s16x4 vtr(LAS unsigned char* p) { return __builtin_bit_cast(s16x4, __builtin_amdgcn_ds_read_tr16_b64_v4i16((LAS v4i16_t*)p)); }
#define MFMA16(a, b, c) __builtin_amdgcn_mfma_f32_16x16x32_bf16((a), (b), (c), 0, 0, 0)
#define LDS_WAIT() asm volatile("s_waitcnt lgkmcnt(0)" ::: "memory")

namespace pg8 {
constexpr int BM = 256, BK = 64, HALF = 128, HTB = HALF * BK * 2, STAGE_BYTES = 8 * HTB, NXCD = 8, WGM = 8;
__host__ __device__ __forceinline__ int lds_byte(int r, int c) { const int st = (r >> 4) * 2 + (c >> 5), rr = r & 15, cc = c & 31, ob = rr * 64 + cc * 2; return st * 1024 + (ob ^ (((ob >> 9) & 1) << 5)); }
__host__ __device__ __forceinline__ void stage_rc(int b, int& R, int& C) { const int st = b / 1024, sb = b % 1024, swz = sb ^ (((sb >> 9) & 1) << 5); R = (st >> 1) * 16 + swz / 64; C = (st & 1) * 32 + (swz % 64) / 2; }
__host__ __device__ __forceinline__ int perm32(int rho) { const int n = rho >> 4, i = rho & 15; return 8 * (i >> 2) + 4 * n + (i & 3); }

struct Unit { int pm, pn, L; };
struct Gemm { const GAS bf16_t* A; const GAS bf16_t* Bt; int M, N, K, lda, ldb; };


constexpr int KVC_G0 = 32 * 128, KVC_G1 = KVC_G0 + 32 * 512, KVC_ROWS = KVC_G1 + 32 * 2048;
__device__ __forceinline__ void kvc_row(int R, const char* s0, const char* s1, const char* s2, char* dbase, const GAS f32x4*& src, GAS f32x4*& dst) {
    const char* sb = R < KVC_G0 ? s0 : (R < KVC_G1 ? s1 : s2);
    const int dg = R < KVC_G0 ? R : (R < KVC_G1 ? R - KVC_G0 : R - KVC_G1), gl = R < KVC_G0 ? KVC_G0 - 1 : (R < KVC_G1 ? 32 * 512 - 1 : 32 * 2048 - 1);
    const int sr = dg + 8 < gl ? dg + 8 : gl;
    src = (const GAS f32x4*)(sb + (size_t)sr * 8192); dst = (GAS f32x4*)(dbase + (size_t)R * 8192);
}

struct NoSide { static constexpr bool ACTIVE = false; __device__ __forceinline__ void step(int, int) {} __device__ __forceinline__ void finish() {} };
struct SideKvCopy {
    static constexpr bool ACTIVE = true;
    f32x4 v; GAS f32x4* dprev; unsigned voff; const char* s0; const char* s1; const char* s2; char* dbase;
    __device__ __forceinline__ void init(GAS f32x4* dummy, const void* c0, const void* c1, const void* c2, float* out) {
        v = (f32x4){0.f, 0.f, 0.f, 0.f}; dprev = dummy; voff = threadIdx.x * 16u; s0 = (const char*)c0; s1 = (const char*)c1; s2 = (const char*)c2; dbase = (char*)(out + O_SKV128); }
    __device__ __forceinline__ void step(int L, int j) {
        asm volatile("global_store_dwordx4 %0, %1, %2 nt" :: "v"(voff), "v"(v), "s"(dprev) : "memory");
        const GAS f32x4* sp; GAS f32x4* dp; kvc_row((L * 16 + j) % KVC_ROWS, s0, s1, s2, dbase, sp, dp);
        asm volatile("global_load_dwordx4 %0, %1, %2 nt" : "=v"(v) : "v"(voff), "s"(sp) : "memory");
        dprev = dp;
    }
    __device__ __forceinline__ void finish() { asm volatile("s_waitcnt vmcnt(0)\n\tglobal_store_dwordx4 %0, %1, %2 nt" :: "v"(voff), "v"(v), "s"(dprev) : "memory"); }
};

struct StaticOrder {
    int nM, nN, nwg, G, c, nrep;
    __host__ __device__ void init(int M, int N, int G_, int c_, int nrep_ = 1) { nM = M / BM; nN = N / BM; nwg = nM * nN; G = G_; c = c_; nrep = nrep_; }
    __host__ __device__ bool next(int i, Unit& u) const {
        const long L = (long)i * G + c; if (L >= (long)nwg * nrep) return false;
        int wgid = (int)(L % nwg); { const int q = nwg / NXCD, r = nwg % NXCD, xcd = wgid % NXCD, off = wgid / NXCD; wgid = (xcd < r ? xcd * (q + 1) : r * (q + 1) + (xcd - r) * q) + off; }
        const int nig = WGM * nN, gid = wgid / nig, fm = gid * WGM, gsz = (nM - fm) < WGM ? (nM - fm) : WGM;
        u.pm = fm + ((wgid % nig) % gsz); u.pn = (wgid % nig) / gsz; u.L = (int)L; return true;
    }
    __device__ __forceinline__ void a_ready(const Unit&) const {}
    __device__ __forceinline__ void done(const Unit&) const {}
};


struct EpiProj {
    static constexpr bool PERM = true, AFTER_DRAIN = false;
    GAS bf16_t* O; int ldc; GAS float* DT; GAS bf16_t* KVC;
    __device__ __forceinline__ void operator()(const f32x4 (&acc)[2][2][4][2], const Unit& u, int wr, int wc, int fr, int fq) const {
        const int row0 = u.pm * BM + wr * 64 + fr;
        if (u.pn == 80) {
            if (wc == 0) {
#pragma unroll
                for (int ai = 0; ai < 2; ++ai)
#pragma unroll
                    for (int m = 0; m < 4; ++m) { GAS float* rp = DT + (size_t)(row0 + ai * HALF + m * 16) * 32 + 8 * fq;
                        *(GAS f32x4*)(rp) = acc[ai][0][m][0]; *(GAS f32x4*)(rp + 4) = acc[ai][0][m][1]; }
            }
        } else if (u.pn >= 12 && u.pn < 36 && u.pm < 64) {
            const int t12 = u.pn - 12, kvsel = t12 >= 12 ? 1 : 0, r12 = t12 - 12 * kvsel, g = r12 >> 2, hq = r12 & 3, sh = 2 * g, dim = wc * 32 + 8 * fq;
#pragma unroll
            for (int ai = 0; ai < 2; ++ai)
#pragma unroll
                for (int m = 0; m < 4; ++m) { const int row = row0 + ai * HALF + m * 16, b = row >> 12, t = row & 4095, ridx = ((t & ((1 << sh) - 1)) << (12 - sh)) + (t >> sh);
#pragma unroll
                    for (int bj = 0; bj < 2; ++bj) { const f32x4 v0 = acc[ai][bj][m][0], v1 = acc[ai][bj][m][1];
                        u32x4 w; w.x = cvt_pk_bf16(v0[0], v0[1]); w.y = cvt_pk_bf16(v0[2], v0[3]); w.z = cvt_pk_bf16(v1[0], v1[1]); w.w = cvt_pk_bf16(v1[2], v1[3]);
                        *(GAS u32x4*)(KVC + ((size_t)((((kvsel * 3 + g) * 4 + b) * 8) + 2 * hq + bj) << 19) + (size_t)ridx * 128 + dim) = w; } }
        } else {
            const int col0 = u.pn * BM + wc * 32 + 8 * fq;
#pragma unroll
            for (int ai = 0; ai < 2; ++ai)
#pragma unroll
                for (int m = 0; m < 4; ++m) { GAS bf16_t* rowp = O + (size_t)(row0 + ai * HALF + m * 16) * ldc + col0;
#pragma unroll
                    for (int bj = 0; bj < 2; ++bj) { const f32x4 v0 = acc[ai][bj][m][0], v1 = acc[ai][bj][m][1];
                        u32x4 w; w.x = cvt_pk_bf16(v0[0], v0[1]); w.y = cvt_pk_bf16(v0[2], v0[3]); w.z = cvt_pk_bf16(v1[0], v1[1]); w.w = cvt_pk_bf16(v1[2], v1[3]);
                        *(GAS u32x4*)(rowp + bj * HALF) = w; } }
        }
    }
};
struct EpiGateA {
    static constexpr bool PERM = true, AFTER_DRAIN = false;
    const GAS bf16_t* gate; int ldg; GAS bf16_t* T;
    __device__ __forceinline__ void operator()(const f32x4 (&acc)[2][2][4][2], const Unit& u, int wr, int wc, int fr, int fq) const {
        const int row0 = u.pm * BM + wr * 64 + fr, col0 = u.pn * BM + wc * 32 + 8 * fq;
#pragma unroll
        for (int ai = 0; ai < 2; ++ai) {
            u32x4 gwv[4][2];
#pragma unroll
            for (int m = 0; m < 4; ++m)
#pragma unroll
                for (int bj = 0; bj < 2; ++bj) gwv[m][bj] = *(const GAS u32x4*)(gate + (size_t)(row0 + ai * HALF + m * 16) * ldg + col0 + bj * HALF);
            __builtin_amdgcn_sched_barrier(0);
#pragma unroll
            for (int m = 0; m < 4; ++m) { const size_t row = (size_t)(row0 + ai * HALF + m * 16);
#pragma unroll
                for (int bj = 0; bj < 2; ++bj) { const int col = col0 + bj * HALF;
                    const u32x4 gw = gwv[m][bj];
                    f32x4 v0 = acc[ai][bj][m][0], v1 = acc[ai][bj][m][1];
                    v0[0] *= sigmoid_f(bf_lo(gw.x)); v0[1] *= sigmoid_f(bf_hi(gw.x)); v0[2] *= sigmoid_f(bf_lo(gw.y)); v0[3] *= sigmoid_f(bf_hi(gw.y));
                    v1[0] *= sigmoid_f(bf_lo(gw.z)); v1[1] *= sigmoid_f(bf_hi(gw.z)); v1[2] *= sigmoid_f(bf_lo(gw.w)); v1[3] *= sigmoid_f(bf_hi(gw.w));
                    u32x4 w; w.x = cvt_pk_bf16(v0[0], v0[1]); w.y = cvt_pk_bf16(v0[2], v0[3]); w.z = cvt_pk_bf16(v1[0], v1[1]); w.w = cvt_pk_bf16(v1[2], v1[3]);
                    *(GAS u32x4*)(T + row * DM + col) = w; } } }
    }
};
struct EpiGateB {
    static constexpr bool PERM = true, AFTER_DRAIN = false;
    const GAS bf16_t* gate; int ldg; const GAS bf16_t* T; GAS bf16_t* O;
    __device__ __forceinline__ void operator()(const f32x4 (&acc)[2][2][4][2], const Unit& u, int wr, int wc, int fr, int fq) const {
        const int row0 = u.pm * BM + wr * 64 + fr, col0 = u.pn * BM + wc * 32 + 8 * fq;
#pragma unroll
        for (int ai = 0; ai < 2; ++ai) {
            u32x4 gwv[4][2], twv[4][2];
#pragma unroll
            for (int m = 0; m < 4; ++m)
#pragma unroll
                for (int bj = 0; bj < 2; ++bj) { const size_t row = (size_t)(row0 + ai * HALF + m * 16); const int col = col0 + bj * HALF;
                    gwv[m][bj] = *(const GAS u32x4*)(gate + row * ldg + col); twv[m][bj] = *(const GAS u32x4*)(T + row * DM + col); }
            __builtin_amdgcn_sched_barrier(0);
#pragma unroll
            for (int m = 0; m < 4; ++m) { const size_t row = (size_t)(row0 + ai * HALF + m * 16);
#pragma unroll
                for (int bj = 0; bj < 2; ++bj) { const int col = col0 + bj * HALF;
                    const u32x4 gw = gwv[m][bj];
                    const u32x4 tw = twv[m][bj];
                    f32x4 v0 = acc[ai][bj][m][0], v1 = acc[ai][bj][m][1];
                    v0[0] = bf_lo(tw.x) + v0[0] * sigmoid_f(bf_lo(gw.x)); v0[1] = bf_hi(tw.x) + v0[1] * sigmoid_f(bf_hi(gw.x)); v0[2] = bf_lo(tw.y) + v0[2] * sigmoid_f(bf_lo(gw.y)); v0[3] = bf_hi(tw.y) + v0[3] * sigmoid_f(bf_hi(gw.y));
                    v1[0] = bf_lo(tw.z) + v1[0] * sigmoid_f(bf_lo(gw.z)); v1[1] = bf_hi(tw.z) + v1[1] * sigmoid_f(bf_hi(gw.z)); v1[2] = bf_lo(tw.w) + v1[2] * sigmoid_f(bf_lo(gw.w)); v1[3] = bf_hi(tw.w) + v1[3] * sigmoid_f(bf_hi(gw.w));
                    u32x4 w; w.x = cvt_pk_bf16(v0[0], v0[1]); w.y = cvt_pk_bf16(v0[2], v0[3]); w.z = cvt_pk_bf16(v1[0], v1[1]); w.w = cvt_pk_bf16(v1[2], v1[3]);
                    *(GAS u32x4*)(O + row * DM + col) = w; } } }
    }
};
struct EpiOutBf16 {
    static constexpr bool PERM = true, AFTER_DRAIN = false;
    GAS bf16_t* O; int ldc;
    __device__ __forceinline__ void operator()(const f32x4 (&acc)[2][2][4][2], const Unit& u, int wr, int wc, int fr, int fq) const {
        const int row0 = u.pm * BM + wr * 64 + fr, col0 = u.pn * BM + wc * 32 + 8 * fq;
#pragma unroll
        for (int ai = 0; ai < 2; ++ai)
#pragma unroll
            for (int m = 0; m < 4; ++m) { GAS bf16_t* rowp = O + (size_t)(row0 + ai * HALF + m * 16) * ldc + col0;
#pragma unroll
                for (int bj = 0; bj < 2; ++bj) { const f32x4 v0 = acc[ai][bj][m][0], v1 = acc[ai][bj][m][1];
                    u32x4 w; w.x = cvt_pk_bf16(v0[0], v0[1]); w.y = cvt_pk_bf16(v0[2], v0[3]); w.z = cvt_pk_bf16(v1[0], v1[1]); w.w = cvt_pk_bf16(v1[2], v1[3]);
                    *(GAS u32x4*)(rowp + bj * HALF) = w; } }
    }
};
struct EpiF32 {
    static constexpr bool PERM = false, AFTER_DRAIN = false;
    GAS float* C; int ldc;
    __device__ __forceinline__ void operator()(const f32x4 (&acc)[2][2][4][2], const Unit& u, int wr, int wc, int fr, int fq) const {
        const int row0 = u.pm * BM + wr * 64 + fr, col0 = u.pn * BM + wc * 32 + 4 * fq;
#pragma unroll
        for (int ai = 0; ai < 2; ++ai)
#pragma unroll
            for (int m = 0; m < 4; ++m) { GAS float* rowp = C + (size_t)(row0 + ai * HALF + m * 16) * ldc + col0;
#pragma unroll
                for (int bj = 0; bj < 2; ++bj)
#pragma unroll
                    for (int n = 0; n < 2; ++n) *(GAS f32x4*)(rowp + bj * HALF + n * 16) = acc[ai][bj][m][n]; }
    }
};

template <class Epi, class Sched, bool ALIGN_EPI = false, bool SP2 = false, class Side = NoSide>
__device__ __forceinline__ void gemm_phase(LAS unsigned char* lds, const Gemm g, const Sched& S, const Epi& E, Side side = Side()) {
    const int tid = threadIdx.x, wid = __builtin_amdgcn_readfirstlane(tid >> 6), lane = tid & 63, wr = wid >> 2, wc = wid & 3, fr = lane & 15, fq = lane >> 4;
    const int K = g.K, nt = K / BK;
    unsigned voffA[2], voffB[2];
#pragma unroll
    for (int i = 0; i < 2; ++i) { int R, C; stage_rc(tid * 16 + i * 8192, R, C); const int Rb = Epi::PERM ? ((R & ~31) + perm32(R & 31)) : R;
        voffA[i] = (unsigned)(R * g.lda + C) * 2u; voffB[i] = (unsigned)(Rb * g.ldb + C) * 2u; }
    const size_t kstep = (size_t)(BK * 2);
    const size_t hstepA = (size_t)HALF * g.lda * 2, hstepB = (size_t)HALF * g.ldb * 2;
    const size_t tstepA = 2 * hstepA, tstepB = 2 * hstepB;
    const unsigned ldsw = (unsigned)wid * 1024u;
    const int aoff = lds_byte(wr * 64 + fr, fq * 8), boff = lds_byte(wc * 32 + fr, fq * 8);
#define PG8_SA(b, h) (((b) * 2 + (h)) * HTB)
#define PG8_SB(b, h) ((4 + (b) * 2 + (h)) * HTB)
#define PG8_STAGE(bufoff, gbase, voff) do { _Pragma("unroll") for (int _i = 0; _i < 2; ++_i) \
        __builtin_amdgcn_global_load_lds((const GAS unsigned*)((gbase) + (voff)[_i]), (LAS unsigned*)(lds + (bufoff) + ldsw + _i * 8192), 16, 0, 0); } while (0)
#define PG8_LDA(dst, b, h) do { _Pragma("unroll") for (int m = 0; m < 4; ++m) _Pragma("unroll") for (int k = 0; k < 2; ++k) dst[m][k] = *(const LAS bf16x8*)(lds + PG8_SA(b, h) + aoff + m * 2048 + k * 1024); } while (0)
#define PG8_LDB(dst, b, h) do { _Pragma("unroll") for (int n = 0; n < 2; ++n) _Pragma("unroll") for (int k = 0; k < 2; ++k) dst[n][k] = *(const LAS bf16x8*)(lds + PG8_SB(b, h) + boff + n * 2048 + k * 1024); } while (0)
#define PG8_MMA(ai, bj, At, Bt) do { __builtin_amdgcn_s_setprio(1); _Pragma("unroll") for (int m = 0; m < 4; ++m) _Pragma("unroll") for (int n = 0; n < 2; ++n) _Pragma("unroll") for (int k = 0; k < 2; ++k) \
        acc[ai][bj][m][n] = __builtin_amdgcn_mfma_f32_16x16x32_bf16(Bt[n][k], At[m][k], acc[ai][bj][m][n], 0, 0, 0); __builtin_amdgcn_s_setprio(0); } while (0)
#define PG8_WAIT_V(n) asm volatile("s_waitcnt vmcnt(" #n ")" ::: "memory")
#define PG8_WAIT_L(n) asm volatile("s_waitcnt lgkmcnt(" #n ")" ::: "memory")
#define PG8_BAR __builtin_amdgcn_s_barrier()
#define PG8_SCHED __builtin_amdgcn_sched_barrier(0)
    Unit cur, nxt; int ui = 0;
    if (!S.next(0, cur)) return;
    f32x4 acc[2][2][4][2];
#pragma unroll
    for (int a = 0; a < 2; ++a)
#pragma unroll
        for (int b = 0; b < 2; ++b)
#pragma unroll
            for (int m = 0; m < 4; ++m)
#pragma unroll
                for (int n = 0; n < 2; ++n) acc[a][b][m][n] = (f32x4){0.f, 0.f, 0.f, 0.f};
    bf16x8 At[4][2], B0[2][2], B1[2][2];
    const GAS char* cA = (const GAS char*)g.A + (size_t)cur.pm * tstepA; const GAS char* cB = (const GAS char*)g.Bt + (size_t)cur.pn * tstepB;
    S.a_ready(cur);
    if constexpr (SP2) {
        PG8_STAGE(PG8_SB(0, 0), cB, voffB); PG8_STAGE(PG8_SB(0, 1), cB + hstepB, voffB); PG8_STAGE(PG8_SA(0, 0), cA, voffA); PG8_STAGE(PG8_SA(0, 1), cA + hstepA, voffA);
        if (wr == 1) PG8_BAR;
        PG8_WAIT_V(2); PG8_BAR;
        PG8_STAGE(PG8_SB(1, 0), cB + kstep, voffB); PG8_STAGE(PG8_SA(1, 0), cA + kstep, voffA); PG8_STAGE(PG8_SB(1, 1), cB + hstepB + kstep, voffB);
        PG8_WAIT_V(6); PG8_BAR;
    } else {
        PG8_STAGE(PG8_SB(0, 0), cB, voffB); PG8_STAGE(PG8_SA(0, 0), cA, voffA); PG8_STAGE(PG8_SB(0, 1), cB + hstepB, voffB); PG8_STAGE(PG8_SA(0, 1), cA + hstepA, voffA);
        if (wr == 1) PG8_BAR;
        PG8_WAIT_V(4); PG8_BAR;
        PG8_STAGE(PG8_SB(1, 0), cB + kstep, voffB); PG8_STAGE(PG8_SA(1, 0), cA + kstep, voffA); PG8_STAGE(PG8_SB(1, 1), cB + hstepB + kstep, voffB);
        PG8_WAIT_V(6); PG8_BAR;
    }
    for (;;) {
        const bool has_next = S.next(ui + 1, nxt);
        const GAS char* nA = has_next ? (const GAS char*)g.A + (size_t)nxt.pm * tstepA : cA; const GAS char* nB = has_next ? (const GAS char*)g.Bt + (size_t)nxt.pn * tstepB : cB;
        for (int t = 0; t < nt; t += 2) {
            const bool last = (t == nt - 2);
            const GAS char* a1 = cA + (size_t)(t + 1) * kstep;
            const GAS char* a2 = last ? nA : cA + (size_t)(t + 2) * kstep; const GAS char* b2 = last ? nB : cB + (size_t)(t + 2) * kstep;
            const GAS char* a3 = a2 + kstep; const GAS char* b3 = b2 + kstep;
            if (last && has_next) S.a_ready(nxt);
            if constexpr (SP2) {
            PG8_LDB(B0, 0, 0); PG8_LDB(B1, 0, 1); PG8_SCHED; PG8_LDA(At, 0, 0); PG8_STAGE(PG8_SA(1, 1), a1 + hstepA, voffA);
            PG8_WAIT_V(8); PG8_WAIT_L(0); PG8_BAR; PG8_MMA(0, 0, At, B0); PG8_MMA(0, 1, At, B1); PG8_BAR; PG8_SCHED;
            PG8_LDA(At, 0, 1); PG8_STAGE(PG8_SB(0, 0), b2, voffB); PG8_STAGE(PG8_SB(0, 1), b2 + hstepB, voffB); PG8_STAGE(PG8_SA(0, 0), a2, voffA);
            if constexpr (Side::ACTIVE) { side.step(cur.L, t >> 1); PG8_WAIT_V(10); } else { PG8_WAIT_V(8); }
            PG8_WAIT_L(0); PG8_BAR; PG8_MMA(1, 0, At, B0); PG8_MMA(1, 1, At, B1); PG8_BAR; PG8_SCHED;
            PG8_LDB(B0, 1, 0); PG8_LDB(B1, 1, 1); PG8_SCHED; PG8_LDA(At, 1, 0); PG8_STAGE(PG8_SA(0, 1), a2 + hstepA, voffA);
            if constexpr (Side::ACTIVE) { PG8_WAIT_V(10); } else { PG8_WAIT_V(8); }
            PG8_WAIT_L(0); PG8_BAR; PG8_MMA(0, 0, At, B0); PG8_MMA(0, 1, At, B1); PG8_BAR; PG8_SCHED;
            PG8_LDA(At, 1, 1); PG8_STAGE(PG8_SB(1, 0), b3, voffB); PG8_STAGE(PG8_SB(1, 1), b3 + hstepB, voffB); PG8_STAGE(PG8_SA(1, 0), a3, voffA);
            PG8_WAIT_V(8); PG8_WAIT_L(0); PG8_BAR; PG8_MMA(1, 0, At, B0); PG8_MMA(1, 1, At, B1); PG8_BAR; PG8_SCHED;
            } else {
            PG8_LDB(B0, 0, 0); PG8_SCHED; PG8_LDA(At, 0, 0); PG8_STAGE(PG8_SA(1, 1), a1 + hstepA, voffA);
            PG8_WAIT_L(8); PG8_BAR; PG8_WAIT_L(0); PG8_MMA(0, 0, At, B0); PG8_BAR; PG8_SCHED;
            PG8_LDB(B1, 0, 1); PG8_STAGE(PG8_SB(0, 0), b2, voffB);
            PG8_BAR; PG8_WAIT_L(0); PG8_MMA(0, 1, At, B1); PG8_BAR;
            PG8_LDA(At, 0, 1); PG8_STAGE(PG8_SA(0, 0), a2, voffA);
            PG8_BAR; PG8_WAIT_L(0); PG8_MMA(1, 0, At, B0); PG8_BAR; PG8_SCHED;
            PG8_STAGE(PG8_SB(0, 1), b2 + hstepB, voffB);
            PG8_WAIT_V(6); PG8_BAR; PG8_MMA(1, 1, At, B1); PG8_BAR;
            PG8_LDB(B0, 1, 0); PG8_SCHED; PG8_LDA(At, 1, 0); PG8_STAGE(PG8_SA(0, 1), a2 + hstepA, voffA);
            PG8_WAIT_L(8); PG8_BAR; PG8_WAIT_L(0); PG8_MMA(0, 0, At, B0); PG8_BAR; PG8_SCHED;
            PG8_LDB(B1, 1, 1); PG8_STAGE(PG8_SB(1, 0), b3, voffB);
            PG8_BAR; PG8_WAIT_L(0); PG8_MMA(0, 1, At, B1); PG8_BAR;
            PG8_LDA(At, 1, 1); PG8_STAGE(PG8_SA(1, 0), a3, voffA);
            PG8_BAR; PG8_WAIT_L(0); PG8_MMA(1, 0, At, B0); PG8_BAR; PG8_SCHED;
            PG8_STAGE(PG8_SB(1, 1), b3 + hstepB, voffB);
            PG8_WAIT_V(6); PG8_BAR; PG8_MMA(1, 1, At, B1); PG8_BAR;
            }
        }
        if constexpr (ALIGN_EPI) { if (wr == 0) PG8_BAR; }
        if constexpr (!Epi::AFTER_DRAIN) { E(acc, cur, wr, wc, fr, fq); S.done(cur); }
        if (!has_next) break;
#pragma unroll
        for (int a = 0; a < 2; ++a)
#pragma unroll
            for (int b = 0; b < 2; ++b)
#pragma unroll
                for (int m = 0; m < 4; ++m)
#pragma unroll
                    for (int n = 0; n < 2; ++n) acc[a][b][m][n] = (f32x4){0.f, 0.f, 0.f, 0.f};
        cur = nxt; cA = nA; cB = nB; ++ui;
        if constexpr (ALIGN_EPI) { if (wr == 1) PG8_BAR; }
    }
    PG8_WAIT_V(0);
    if constexpr (Side::ACTIVE) side.finish();
    if constexpr (!ALIGN_EPI) { if (wr == 0) PG8_BAR; }
    PG8_BAR;
#undef PG8_SA
#undef PG8_SB
#undef PG8_STAGE
#undef PG8_LDA
#undef PG8_LDB
#undef PG8_MMA
#undef PG8_WAIT_V
#undef PG8_WAIT_L
#undef PG8_BAR
#undef PG8_SCHED
}
}

#define XB_TMO      128
#define XB_XCNT(j)  (256  + 64 * (j))
#define XB_XSUB(j)  (1280 + 64 * (j))
#define XB_XGEN(j)  (2304 + 64 * (j))
#define XB_TOP      3328
#define XB_TOPGEN   3392
#define XCD_BAR_WORDS 3456
#define XB_SPIN_CAP (1u << 18)

__device__ __forceinline__ unsigned xb_ld(unsigned* p)              { return __hip_atomic_load(p, __ATOMIC_RELAXED, __HIP_MEMORY_SCOPE_AGENT); }
__device__ __forceinline__ unsigned xb_add(unsigned* p, unsigned v) { return __hip_atomic_fetch_add(p, v, __ATOMIC_RELAXED, __HIP_MEMORY_SCOPE_AGENT); }
__device__ __forceinline__ unsigned xb_xcc_id() { return (unsigned)__builtin_amdgcn_s_getreg((3 << 11) | 20) & 0xFu; }
#define XB_SPIN(cond, bar) do { unsigned _sp = 0; while (cond) { __builtin_amdgcn_s_sleep(1); \
    if ((++_sp & 255u) == 0u) { if (xb_ld(&(bar)[XB_TMO])) break; if (_sp > XB_SPIN_CAP) { atomicAdd(&(bar)[XB_TMO], 1u); break; } } } } while (0)

struct XcdBarrier { unsigned* bar; unsigned x; volatile LAS unsigned* st; };

__device__ __forceinline__ XcdBarrier xcd_barrier_post(unsigned* bar, volatile LAS unsigned* st) {
    XcdBarrier b; b.bar = bar; b.x = xb_xcc_id(); b.st = st;
    if (threadIdx.x == 0) (void)xb_add(&bar[XB_XCNT(b.x)], 1u);
    return b;
}
__device__ __forceinline__ void xcd_barrier_complete(unsigned* bar, unsigned x, unsigned& nloc, unsigned& nx) {
    const unsigned G = gridDim.x * gridDim.y * gridDim.z;
    unsigned sum, cnt, mine, sp = 0u;
    for (;;) {
        sum = 0u; cnt = 0u; mine = 0u;
#pragma unroll
        for (unsigned j = 0; j < 16; ++j) { const unsigned c = xb_ld(&bar[XB_XCNT(j)]); sum += c; cnt += (c > 0u) ? 1u : 0u; mine = (j == x) ? c : mine; }
        if (sum == G) break;
        __builtin_amdgcn_s_sleep(1);
        if ((++sp & 255u) == 0u) { if (xb_ld(&bar[XB_TMO])) break; if (sp > XB_SPIN_CAP) { atomicAdd(&bar[XB_TMO], 1u); break; } }
    }
    nloc = mine > 0u ? mine : 1u; nx = cnt > 0u ? cnt : 1u;
}
__device__ __forceinline__ void xcd_barrier(const XcdBarrier& b) {
    asm volatile("s_waitcnt vmcnt(0)" ::: "memory");
    __syncthreads();
    if (threadIdx.x == 0) {
        unsigned* bar = b.bar;
        __builtin_amdgcn_s_waitcnt(0);
        unsigned nloc = b.st[0], nx = b.st[1];
        if (nloc == 0u) { xcd_barrier_complete(bar, b.x, nloc, nx); b.st[0] = nloc; b.st[1] = nx; }
        const unsigned old = xb_add(&bar[XB_XSUB(b.x)], 1u);
        const unsigned gen = old / nloc;
        if (old + 1u == (gen + 1u) * nloc) {
            __builtin_amdgcn_fence(__ATOMIC_RELEASE, "agent");
            asm volatile("s_waitcnt vmcnt(0)" ::: "memory");
            const unsigned og = xb_add(&bar[XB_TOP], 1u);
            const unsigned tg = og / nx;
            if (og + 1u == (tg + 1u) * nx) xb_add(&bar[XB_TOPGEN], 1u);
            else XB_SPIN(xb_ld(&bar[XB_TOPGEN]) == tg, bar);
            __builtin_amdgcn_fence(__ATOMIC_ACQUIRE, "agent");
            xb_add(&bar[XB_XGEN(b.x)], 1u);
            asm volatile("s_waitcnt vmcnt(0)" ::: "memory");
        } else {
            XB_SPIN(xb_ld(&bar[XB_XGEN(b.x)]) == gen, bar);
            __builtin_amdgcn_fence(__ATOMIC_ACQUIRE, "agent");
            asm volatile("s_waitcnt vmcnt(0)" ::: "memory");
        }
    }
    __syncthreads();
}

struct Args { const void* in[23]; float* out; unsigned char* ws; int ph_lo, ph_hi; };

__device__ __forceinline__ unsigned char* fresh_ws(const Args& A) { unsigned char* w = A.ws; asm volatile("" : "+s"(w)); return w; }
struct Ctx {
    LAS unsigned char* lds;
    int tid, lane, wave, bid, G;
};

__device__ __forceinline__ void tr_item(const GAS float* W, int ldw, int src_n0, int k0, GAS bf16_t* WT, int ldt, int dst_n0, int dst_k0, LAS float* scr, int lane) {
    const int c = lane & 7;
    if (src_n0 < 0) {
#pragma unroll
        for (int j = 0; j < 4; ++j) { const int n = (lane >> 3) + 8 * j; *(GAS u32x4*)(WT + (size_t)(dst_n0 + n) * ldt + dst_k0 + k0 + 8 * c) = (u32x4){0u, 0u, 0u, 0u}; }
        return;
    }
#pragma unroll 8
    for (int i = 0; i < 32; ++i) { const int kk = 2 * i + (lane >> 5); scr[kk * 33 + (lane & 31)] = W[(size_t)(k0 + kk) * ldw + src_n0 + (lane & 31)]; }
    LDS_WAIT(); asm volatile("" ::: "memory");
#pragma unroll
    for (int j = 0; j < 4; ++j) { const int n = (lane >> 3) + 8 * j; const LAS float* s = scr + (8 * c) * 33 + n;
        u32x4 o; o.x = cvt_pk_bf16(s[0 * 33], s[1 * 33]); o.y = cvt_pk_bf16(s[2 * 33], s[3 * 33]); o.z = cvt_pk_bf16(s[4 * 33], s[5 * 33]); o.w = cvt_pk_bf16(s[6 * 33], s[7 * 33]);
        *(GAS u32x4*)(WT + (size_t)(dst_n0 + n) * ldt + dst_k0 + k0 + 8 * c) = o; }
    LDS_WAIT(); asm volatile("" ::: "memory");
}

__device__ __forceinline__ void mod_item(const Ctx& X, const GAS float* cp, const GAS float* cs, const GAS float* w_ada, const GAS float* b_ada, GAS float* mod, int it) {
    LAS float* sc = (LAS float*)X.lds;
    LAS float* red = (LAS float*)(X.lds + 36864);
    const int tid = X.tid, col = tid & 31, kg = tid >> 5, n = it * 32 + col;
    f32x2 acc[18];
#pragma unroll
    for (int r = 0; r < 18; ++r) acc[r] = (f32x2){0.f, 0.f};
    float wn[16], cn[18];
#define MOD_LOAD(slab_) do { _Pragma("unroll") for (int kk = 0; kk < 16; ++kk) wn[kk] = w_ada[(size_t)((slab_) * 256 + kg * 16 + kk) * 6144 + n]; \
        _Pragma("unroll") for (int q = 0; q < 18; ++q) { const int e = tid + 512 * q, r = e >> 8, k = e & 255; cn[q] = (r < 4) ? cp[r * DM + (slab_) * 256 + k] : cs[(r - 4) * DM + (slab_) * 256 + k]; } } while (0)
    MOD_LOAD(0);
    for (int slab = 0; slab < 8; ++slab) {
        __syncthreads();
#pragma unroll
        for (int q = 0; q < 18; ++q) { const int e = tid + 512 * q, r = e >> 8, k = e & 255; sc[k * 36 + r] = silu_f(cn[q]); }
        float wc[16];
#pragma unroll
        for (int kk = 0; kk < 16; ++kk) wc[kk] = wn[kk];
        if (slab + 1 < 8) MOD_LOAD(slab + 1);
        __syncthreads();
#pragma unroll
        for (int kk = 0; kk < 16; ++kk) { const int k = kg * 16 + kk; const float w = wc[kk];
            const LAS f32x4* s4 = (const LAS f32x4*)(sc + k * 36);
#pragma unroll
            for (int r4 = 0; r4 < 9; ++r4) { const f32x4 v = s4[r4]; const f32x2 ww = (f32x2){w, w};
                acc[2 * r4] = __builtin_elementwise_fma((f32x2){v[0], v[1]}, ww, acc[2 * r4]); acc[2 * r4 + 1] = __builtin_elementwise_fma((f32x2){v[2], v[3]}, ww, acc[2 * r4 + 1]); } }
    }
#undef MOD_LOAD
#pragma unroll
    for (int r = 0; r < 36; ++r) red[(kg * 36 + r) * 32 + col] = acc[r >> 1][r & 1];
    __syncthreads();
    for (int e = tid; e < 36 * 32; e += 512) { const int r = e >> 5, c = e & 31; float s = 0.f;
#pragma unroll
        for (int q = 0; q < 16; ++q) s += red[(q * 36 + r) * 32 + c];
        mod[r * 6144 + it * 32 + c] = s + b_ada[it * 32 + c]; }
    __syncthreads();
}

__device__ __forceinline__ void phase0(const Ctx& X, const Args& A) {
    unsigned char* const wsl = fresh_ws(A);
    unsigned char* ws = wsl;
    const GAS float* w_in = (const GAS float*)A.in[13];
    GAS bf16_t* WIN = (GAS bf16_t*)(ws + WS_WIN);
    LAS float* scr = (LAS float*)(X.lds + X.wave * 8448);
    const int gw = X.bid * 8 + X.wave, NGW = X.G * 8;
    constexpr int NB_IN = NP / 32, I_IN = 32 * NB_IN;
    for (int it = gw; it < I_IN; it += NGW) {
        const int kb = it / NB_IN, nb = it % NB_IN, n0 = nb * 32;
        const int src = n0 < 16384 ? n0 : (n0 < C_DT ? n0 + 32 : (n0 < C_DT + 32 ? 16384 : -1));
        tr_item(w_in, NIN, src, kb * 64, WIN, DM, n0, 0, scr, X.lane);
    }
    for (int it = X.bid; it < 192; it += X.G)
        mod_item(X, (const GAS float*)A.in[7], (const GAS float*)A.in[8], (const GAS float*)A.in[9], (const GAS float*)A.in[10], (GAS float*)(ws + WS_MOD), it);
}

__device__ __forceinline__ void late_weight_transposes(const Ctx& X, const Args& A, int first_wg) {
    unsigned char* const wsl = fresh_ws(A);
    const GAS float* w_o_a = (const GAS float*)A.in[20]; const GAS float* w_o_b = (const GAS float*)A.in[21]; const GAS float* w_o = (const GAS float*)A.in[22];
    GAS bf16_t* WAB = (GAS bf16_t*)(wsl + WS_WAB); GAS bf16_t* WO = (GAS bf16_t*)(wsl + WS_WO);
    LAS float* scr = (LAS float*)(X.lds + X.wave * 8448);
    constexpr int I_OA = 16 * 64, I_OB = 32 * 64, I_O = 32 * 64;
    const int gw = (X.bid - first_wg) * 8 + X.wave, NGW = (X.G - first_wg) * 8;
    for (int it = gw; it < I_OA + I_OB + I_O; it += NGW) {
        int r = it;
        if (r < I_OA) { const int kb = r / 64, nb = r % 64; tr_item(w_o_a, DM, nb * 32, kb * 64, WAB, KAB, nb * 32, 0, scr, X.lane); continue; }
        r -= I_OA;
        if (r < I_OB) { const int kb = r / 64, nb = r % 64; tr_item(w_o_b, DM, nb * 32, kb * 64, WAB, KAB, nb * 32, 1024, scr, X.lane); continue; }
        r -= I_OB;
        { const int kb = r / 64, nb = r % 64; tr_item(w_o, DM, nb * 32, kb * 64, WO, DM, nb * 32, 0, scr, X.lane); }
    }
}

__device__ __forceinline__ void phase1(const Ctx& X, const Args& A) {
    unsigned char* const wsl = fresh_ws(A);
    const GAS float* xp = (const GAS float*)A.in[0]; const GAS float* xs = (const GAS float*)A.in[1]; const GAS float* gpre = (const GAS float*)A.in[11];
    const GAS float* mod = (const GAS float*)(wsl + WS_MOD); GAS bf16_t* H = (GAS bf16_t*)(wsl + WS_H);
    const int gw = X.bid * 8 + X.wave, NGW = X.G * 8, lane = X.lane;
    for (int m = gw; m < MT; m += NGW) {
        const GAS f32x4* xr = (const GAS f32x4*)(m < MP ? xp + (size_t)m * DM : xs + (size_t)(m - MP) * DM);
        const int mb = m < MP ? (m >> 12) : 4 + ((m - MP) >> 3);
        const GAS f32x4* sh4 = (const GAS f32x4*)(mod + mb * 6144); const GAS f32x4* sc4 = sh4 + 512; const GAS f32x4* g4 = (const GAS f32x4*)gpre;
        f32x4 v[8]; float ss = 0.f;
#pragma unroll
        for (int j = 0; j < 8; ++j) v[j] = __builtin_nontemporal_load(xr + lane + 64 * j);
        f32x4 ggv[8], shv[8], scv[8];
#pragma unroll
        for (int j = 0; j < 8; ++j) { ggv[j] = g4[lane + 64 * j]; shv[j] = sh4[lane + 64 * j]; scv[j] = sc4[lane + 64 * j]; }
        __builtin_amdgcn_sched_barrier(0);
#pragma unroll
        for (int j = 0; j < 8; ++j) ss += (v[j][0] * v[j][0] + v[j][1] * v[j][1]) + (v[j][2] * v[j][2] + v[j][3] * v[j][3]);
        const float rstd = rsqrtf(wave_sum(ss) * (1.f / DM) + NORM_EPS);
        GAS u32x2* o = (GAS u32x2*)(H + (size_t)m * DM);
#pragma unroll
        for (int j = 0; j < 8; ++j) { const f32x4 gg = ggv[j], sh = shv[j], sc = scv[j];
            f32x4 y;
#pragma unroll
            for (int e = 0; e < 4; ++e) y[e] = (v[j][e] * rstd * gg[e]) * (1.f + sc[e]) + sh[e];
            u32x2 w; w.x = cvt_pk_bf16(y[0], y[1]); w.y = cvt_pk_bf16(y[2], y[3]); o[lane + 64 * j] = w; }
    }
    { constexpr int R0 = 16 * 65 * 81, NR = (pg8::KVC_ROWS - R0 + 255) / 256;
      for (int Rb = R0 + X.bid; Rb < pg8::KVC_ROWS; Rb += X.G * NR) {
        u32x4 v[NR];
#pragma unroll
        for (int q = 0; q < NR; ++q) { int R = Rb + q * X.G; if (R >= pg8::KVC_ROWS) R = Rb; const GAS f32x4* sp; GAS f32x4* dp; pg8::kvc_row(R, (const char*)A.in[2], (const char*)A.in[3], (const char*)A.in[4], (char*)(A.out + O_SKV128), sp, dp);
            v[q] = *((const GAS u32x4*)sp + X.tid); }
#pragma unroll
        for (int q = 0; q < NR; ++q) { const int R = Rb + q * X.G; if (R < pg8::KVC_ROWS) { const GAS f32x4* sp; GAS f32x4* dp; pg8::kvc_row(R, (const char*)A.in[2], (const char*)A.in[3], (const char*)A.in[4], (char*)(A.out + O_SKV128), sp, dp);
            *((GAS u32x4*)dp + X.tid) = v[q]; } }
      } }
}

__device__ __forceinline__ void unpack8(const u32x4 v, float (&x)[8]) { x[0] = bf_lo(v.x); x[1] = bf_hi(v.x); x[2] = bf_lo(v.y); x[3] = bf_hi(v.y); x[4] = bf_lo(v.z); x[5] = bf_hi(v.z); x[6] = bf_lo(v.w); x[7] = bf_hi(v.w); }
__device__ __forceinline__ void conv_prepass(const Ctx& X, const Args& A) {
    unsigned char* const wsl = fresh_ws(A);
    const GAS bf16_t* proj = (const GAS bf16_t*)(wsl + WS_PROJ); GAS bf16_t* XB = (GAS bf16_t*)(wsl + WS_XBCA); GAS float* DT = (GAS float*)(wsl + WS_DT);
    const GAS float* conv_w = (const GAS float*)A.in[14]; const GAS float* conv_b = (const GAS float*)A.in[15]; const GAS float* hist = (const GAS float*)A.in[5];
    const int gt = X.bid * 512 + X.tid, GT = X.G * 512;
    const int cc = gt & 511, ch0 = cc * 8;
    float wt[4][8], bias[8];
#pragma unroll
    for (int kk = 0; kk < 4; ++kk) { const f32x4 a = *(const GAS f32x4*)(conv_w + kk * 4096 + ch0), b = *(const GAS f32x4*)(conv_w + kk * 4096 + ch0 + 4);
        wt[kk][0] = a[0]; wt[kk][1] = a[1]; wt[kk][2] = a[2]; wt[kk][3] = a[3]; wt[kk][4] = b[0]; wt[kk][5] = b[1]; wt[kk][6] = b[2]; wt[kk][7] = b[3]; }
    { const f32x4 a = *(const GAS f32x4*)(conv_b + ch0), b = *(const GAS f32x4*)(conv_b + ch0 + 4); bias[0] = a[0]; bias[1] = a[1]; bias[2] = a[2]; bias[3] = a[3]; bias[4] = b[0]; bias[5] = b[1]; bias[6] = b[2]; bias[7] = b[3]; }
    for (int run = gt >> 9; run < 1024 + 32; run += GT >> 9) {
        const bool dec = run >= 1024;
        const size_t row_first = dec ? (size_t)MP + (size_t)(run - 1024) * 8 : (size_t)run * 16;
        const int t0 = dec ? 0 : ((run * 16) & 4095), nt = dec ? 8 : 16;
        const GAS bf16_t* src = proj + row_first * NP + C_XBC + ch0;
        float xm[3][8];
        if (t0 >= 3) {
#pragma unroll
            for (int j = 0; j < 3; ++j) unpack8(*(const GAS u32x4*)(src + (long)(j - 3) * NP), xm[j]);
        } else if (dec) {
            const GAS float* hp = hist + (size_t)(run - 1024) * 3 * 4096 + ch0;
#pragma unroll
            for (int j = 0; j < 3; ++j) { const f32x4 a = *(const GAS f32x4*)(hp + j * 4096), b = *(const GAS f32x4*)(hp + j * 4096 + 4);
                xm[j][0] = a[0]; xm[j][1] = a[1]; xm[j][2] = a[2]; xm[j][3] = a[3]; xm[j][4] = b[0]; xm[j][5] = b[1]; xm[j][6] = b[2]; xm[j][7] = b[3]; }
        } else {
#pragma unroll
            for (int j = 0; j < 3; ++j)
#pragma unroll
                for (int e = 0; e < 8; ++e) xm[j][e] = 0.f;
        }
        u32x4 rows[16];
#pragma unroll
        for (int i = 0; i < 16; ++i) rows[i] = (i < nt) ? *(const GAS u32x4*)(src + (size_t)i * NP) : (u32x4){0u, 0u, 0u, 0u};
#pragma unroll
        for (int i = 0; i < 16; ++i) {
            if (i < nt) {
                float cur[8], o[8]; unpack8(rows[i], cur);
#pragma unroll
                for (int e = 0; e < 8; ++e) { o[e] = bias[e] + wt[0][e] * xm[0][e] + wt[1][e] * xm[1][e] + wt[2][e] * xm[2][e] + wt[3][e] * cur[e]; o[e] = silu_f(o[e]);
                    xm[0][e] = xm[1][e]; xm[1][e] = xm[2][e]; xm[2][e] = cur[e]; }
                u32x4 pk; pk.x = cvt_pk_bf16(o[0], o[1]); pk.y = cvt_pk_bf16(o[2], o[3]); pk.z = cvt_pk_bf16(o[4], o[5]); pk.w = cvt_pk_bf16(o[6], o[7]);
                *(GAS u32x4*)(XB + (row_first + i) * 4096 + ch0) = pk;
            }
        }
    }
    const GAS float* dtb = (const GAS float*)A.in[16];
    for (int i0 = gt; i0 < MT * 32; i0 += GT * 5) { float dv[5];
#pragma unroll
        for (int q = 0; q < 5; ++q) { const int i = i0 + q * GT; dv[q] = DT[i < MT * 32 ? i : i0]; }
#pragma unroll
        for (int q = 0; q < 5; ++q) { const int i = i0 + q * GT; if (i < MT * 32) DT[i] = softplus_f(dv[q] + dtb[i & 31]); } }
}

__device__ __forceinline__ float wave_incl_scan(float v, int lane) {
#pragma unroll
    for (int o = 1; o < 64; o <<= 1) { const float t = __shfl_up(v, o); if (lane >= o) v += t; }
    return v;
}
constexpr int T_BM = 0  , T_CM = 65536, T_XD = 98304, T_XW = 118784, T_ST = 139264, T_DTV = 157696, T_CSV = 158720, T_GSV = 159744, T_XS = 160;
__device__ __forceinline__ void ssd_prompt_item64(const Ctx& X, const Args& A, int b, int h) {
    unsigned char* const wsl = fresh_ws(A);
    LAS unsigned char* lds = X.lds;
    const int tid = X.tid, lane = X.lane, w = X.wave, fr = lane & 15, g4 = lane >> 4, gi = h >> 2, q = fr >> 2, pp = fr & 3;
    const GAS bf16_t* proj = (const GAS bf16_t*)(wsl + WS_PROJ); const GAS bf16_t* XB = (const GAS bf16_t*)(wsl + WS_XBCA); const GAS float* DT = (const GAS float*)(wsl + WS_DT); GAS bf16_t* YG = (GAS bf16_t*)(wsl + WS_YG);
    unsigned voff[2];
#pragma unroll
    for (int i = 0; i < 2; ++i) { int R, C; pg8::stage_rc(tid * 16 + i * 8192, R, C); voff[i] = (unsigned)(R * 4096 + C) * 2u; }
    const int lsw = (lane * 16) ^ ((lane >> 5) << 5);
    const unsigned voffc = (unsigned)((16 * w + (lsw >> 6)) * 4096 + ((lsw & 63) >> 1)) * 2u;
    const int lane_base = (fr * 64 + 16 * g4) ^ ((fr >> 3) << 5);
#define SSD_FRAG(base, tile, ks) (*(const LAS bf16x8*)(lds + (base) + ((ks) >> 1) * 16384 + (tile) * 2048 + ((ks) & 1) * 1024 + lane_base))
#define SSD_DMA16(gbase_, voff_, ldsaddr_) asm volatile("s_mov_b32 m0, %2\n\ts_nop 0\n\tglobal_load_lds_dwordx4 %0, %1" :: "v"(voff_), "s"(gbase_), "s"(ldsaddr_) : "memory")
#define SSD_STAGE_B(row0_, buf_) do { const char* gB_ = (const char*)(XB + (size_t)(row0_) * 4096 + 2048 + gi * 128); \
        _Pragma("unroll") for (int kh_ = 0; kh_ < 2; ++kh_) _Pragma("unroll") for (int i_ = 0; i_ < 2; ++i_) \
            SSD_DMA16(gB_ + kh_ * 128, voff[i_], ldsb + (unsigned)(T_BM + (buf_) * 32768 + kh_ * 16384 + w * 1024 + i_ * 8192)); } while (0)
#define SSD_STAGE_C(row0_) do { const char* gC_ = (const char*)(XB + (size_t)(row0_) * 4096 + 3072 + gi * 128); \
        _Pragma("unroll") for (int ks_ = 0; ks_ < 4; ++ks_) \
            SSD_DMA16(gC_ + ks_ * 64, voffc, ldsb + (unsigned)(T_CM + (ks_ >> 1) * 16384 + (2 * w + (ks_ & 1)) * 1024)); } while (0)
    const unsigned ldsb = (unsigned)(size_t)lds;
    __syncthreads();
    const float A_h = -expf(((const GAS float*)A.in[17])[h]), Dh = ((const GAS float*)A.in[18])[h];
    f32x4 sacc[4];
#pragma unroll
    for (int pt = 0; pt < 4; ++pt) sacc[pt] = (f32x4){0.f, 0.f, 0.f, 0.f};
    const int xs0 = tid >> 3, xc8 = tid & 7;
    const unsigned xoff = (unsigned)(xs0 * 4096 + h * 64 + xc8 * 8) * 2u;
    const size_t rowb = (size_t)b * 4096;
    SSD_STAGE_B(rowb, 0); SSD_STAGE_C(rowb);
    u32x4 xr[2];
    { const GAS char* xb = (const GAS char*)(XB + rowb * 4096);
#pragma unroll
      for (int i = 0; i < 2; ++i) xr[i] = *(const GAS u32x4*)(xb + xoff + i * (64 * 8192)); }
    float d0 = 0.f, d1 = 0.f, c0s = 0.f, c1s = 0.f, g0s = 0.f, g1s = 0.f;
    if (w == 0) { d0 = DT[(rowb + lane) * 32 + h]; d1 = DT[(rowb + 64 + lane) * 32 + h];
        c0s = wave_incl_scan(d0 * A_h, lane); c1s = wave_incl_scan(d1 * A_h, lane) + __shfl(c0s, 63);
        g0s = __expf(__shfl(c0s, lane | 15) - c0s); g1s = __expf(__shfl(c1s, lane | 15) - c1s); }
    asm volatile("s_waitcnt vmcnt(0)" : "+v"(xr[0]), "+v"(xr[1]) :: "memory");
    for (int c = 0; c < 32; ++c) {
        const size_t row0 = rowb + (size_t)c * 128;
        const int par = c & 1;
        LAS float* dtv = (LAS float*)(lds + T_DTV + par * 512); LAS float* csv = (LAS float*)(lds + T_CSV + par * 512); LAS float* gsv = (LAS float*)(lds + T_GSV + par * 512);
        if (w == 0) { dtv[lane] = d0; dtv[64 + lane] = d1; csv[lane] = c0s; csv[64 + lane] = c1s; gsv[lane] = g0s; gsv[64 + lane] = g1s; }
        const int bmo = T_BM + par * 32768;
        const size_t rown = (c + 1 < 32) ? row0 + 128 : row0;
        float dn0 = 0.f, dn1 = 0.f;
        if (w == 0) { dn0 = DT[(rown + lane) * 32 + h]; dn1 = DT[(rown + 64 + lane) * 32 + h]; }
        __syncthreads();
#pragma unroll
        for (int pt = 0; pt < 4; ++pt)
#pragma unroll
            for (int r = 0; r < 4; ++r) *(LAS unsigned short*)(lds + T_ST + (16 * pt + 4 * g4 + r) * 288 + (16 * w + fr) * 2) = f2bf(sacc[pt][r]);
        {
            const float cse = csv[127];
#pragma unroll
            for (int i = 0; i < 2; ++i) { const int s = xs0 + 64 * i; const float dts = dtv[s], wgt = __expf(cse - csv[s]);
                float xv[8]; unpack8(xr[i], xv);
#pragma unroll
                for (int e = 0; e < 8; ++e) xv[e] *= dts;
                u32x4 pk; pk.x = cvt_pk_bf16(xv[0], xv[1]); pk.y = cvt_pk_bf16(xv[2], xv[3]); pk.z = cvt_pk_bf16(xv[4], xv[5]); pk.w = cvt_pk_bf16(xv[6], xv[7]);
                *(LAS u32x4*)(lds + T_XD + s * T_XS + xc8 * 16) = pk;
#pragma unroll
                for (int e = 0; e < 8; ++e) xv[e] *= wgt;
                pk.x = cvt_pk_bf16(xv[0], xv[1]); pk.y = cvt_pk_bf16(xv[2], xv[3]); pk.z = cvt_pk_bf16(xv[4], xv[5]); pk.w = cvt_pk_bf16(xv[6], xv[7]);
                *(LAS u32x4*)(lds + T_XW + s * T_XS + xc8 * 16) = pk; }
        }
        __syncthreads();
        f32x4 yacc[4], oacc[4]; float el, skip; u32x2 zq[4], xq[4]; u32x4 xn[2];
        {
            bf16x8 cf[4];
#pragma unroll
            for (int ks = 0; ks < 4; ++ks) cf[ks] = SSD_FRAG(T_CM, w, ks);
            const float cl = csv[16 * w + fr];
            skip = Dh * __builtin_amdgcn_rcpf(fmaxf(dtv[16 * w + fr], 1e-30f));
#pragma unroll
            for (int pt = 0; pt < 4; ++pt) xq[pt] = *(const LAS u32x2*)(lds + T_XD + (16 * w + fr) * T_XS + (16 * pt + 4 * g4) * 2);
            asm volatile("s_waitcnt lgkmcnt(0)" : "+v"(cf[0]), "+v"(cf[1]), "+v"(cf[2]), "+v"(cf[3]) :: "memory");
            if (c + 1 < 32) { SSD_STAGE_B(rown, par ^ 1); SSD_STAGE_C(rown); }
            { const GAS char* xb = (const GAS char*)(XB + rown * 4096);
#pragma unroll
              for (int i = 0; i < 2; ++i) xn[i] = *(const GAS u32x4*)(xb + xoff + i * (64 * 8192)); }
            { const GAS char* zb = (const GAS char*)(proj + (row0 + 16 * w + fr) * NP + C_ZB + h * 64 + 4 * g4);
#pragma unroll
              for (int pt = 0; pt < 4; ++pt) zq[pt] = *(const GAS u32x2*)(zb + 32 * pt); }
#pragma unroll
            for (int pt = 0; pt < 4; ++pt) yacc[pt] = (f32x4){0.f, 0.f, 0.f, 0.f};
            for (int g0 = 0; g0 <= w; g0 += 4) {
                bf16x8 bfr[4][4]; f32x4 gv[4]; float ce[4]; s16x4 xa[2][4][2];
#pragma unroll
                for (int tt = 0; tt < 4; ++tt) { const int tcl = (g0 + tt <= w) ? g0 + tt : w;
#pragma unroll
                    for (int ks = 0; ks < 4; ++ks) bfr[tt][ks] = SSD_FRAG(bmo, tcl, ks);
                    gv[tt] = *(const LAS f32x4*)((tcl == w ? csv : gsv) + 16 * tcl + 4 * g4); ce[tt] = csv[16 * tcl + 15]; }
#pragma unroll
                for (int jj = 0; jj < 2; ++jj)
#pragma unroll
                    for (int pt = 0; pt < 4; ++pt) { const int s0 = 32 * ((g0 >> 1) + jj) + 4 * g4 + q;
                        xa[jj][pt][0] = vtr(lds + T_XD + s0 * T_XS + (16 * pt + 4 * pp) * 2);
                        xa[jj][pt][1] = vtr(lds + T_XD + (s0 + 16) * T_XS + (16 * pt + 4 * pp) * 2); }
                __builtin_amdgcn_sched_barrier(0);
                f32x4 acc[4];
#pragma unroll
                for (int tt = 0; tt < 4; ++tt) acc[tt] = (f32x4){0.f, 0.f, 0.f, 0.f};
#pragma unroll
                for (int ks = 0; ks < 4; ++ks)
#pragma unroll
                    for (int tt = 0; tt < 4; ++tt) acc[tt] = MFMA16(bfr[tt][ks], cf[ks], acc[tt]);
                s16x4 mh[4];
#pragma unroll
                for (int tt = 0; tt < 4; ++tt) { const int t = g0 + tt; float v[4];
                    if (t < w) { const float ft = __expf(cl - ce[tt]);
#pragma unroll
                        for (int r = 0; r < 4; ++r) v[r] = acc[tt][r] * (ft * gv[tt][r]);
                    } else if (t == w) {
#pragma unroll
                        for (int r = 0; r < 4; ++r) { const float e = __expf(fminf(cl - gv[tt][r], 0.f)); v[r] = (4 * g4 + r > fr) ? 0.f : acc[tt][r] * e; }
                    } else { v[0] = v[1] = v[2] = v[3] = 0.f; }
                    mh[tt] = pack4(v[0], v[1], v[2], v[3]); }
#pragma unroll
                for (int jj = 0; jj < 2; ++jj) { const bf16x8 mfrag = cat8(mh[2 * jj], mh[2 * jj + 1]);
#pragma unroll
                    for (int pt = 0; pt < 4; ++pt) yacc[pt] = MFMA16(cat8(xa[jj][pt][0], xa[jj][pt][1]), mfrag, yacc[pt]); }
            }
            bf16x8 sf[4][4];
#pragma unroll
            for (int ks = 0; ks < 4; ++ks)
#pragma unroll
                for (int pt = 0; pt < 4; ++pt) sf[ks][pt] = *(const LAS bf16x8*)(lds + T_ST + (16 * pt + fr) * 288 + (32 * ks + 8 * g4) * 2);
            __builtin_amdgcn_sched_barrier(0);
#pragma unroll
            for (int pt = 0; pt < 4; ++pt) oacc[pt] = (f32x4){0.f, 0.f, 0.f, 0.f};
#pragma unroll
            for (int ks = 0; ks < 4; ++ks)
#pragma unroll
                for (int pt = 0; pt < 4; ++pt) oacc[pt] = MFMA16(sf[ks][pt], cf[ks], oacc[pt]);
            el = __expf(cl);
        }
        {
            const float dtot = __expf(csv[127]);
#pragma unroll
            for (int pt = 0; pt < 4; ++pt) sacc[pt] *= dtot;
            const int ncol = 16 * w + 4 * pp;
#pragma unroll
            for (int kst = 0; kst < 4; ++kst) {
                const int r0 = 32 * kst + 4 * g4 + q;
                const bf16x8 bfrag = cat8(vtr(lds + bmo + (ncol >> 6) * 16384 + pg8::lds_byte(r0, ncol & 63)), vtr(lds + bmo + (ncol >> 6) * 16384 + pg8::lds_byte(r0 + 16, ncol & 63)));
#pragma unroll
                for (int pt = 0; pt < 4; ++pt)
                    sacc[pt] = MFMA16(cat8(vtr(lds + T_XW + r0 * T_XS + (16 * pt + 4 * pp) * 2), vtr(lds + T_XW + (r0 + 16) * T_XS + (16 * pt + 4 * pp) * 2)), bfrag, sacc[pt]);
            }
        }
        if (w == 0) { c0s = wave_incl_scan(dn0 * A_h, lane); c1s = wave_incl_scan(dn1 * A_h, lane) + __shfl(c0s, 63);
            g0s = __expf(__shfl(c0s, lane | 15) - c0s); g1s = __expf(__shfl(c1s, lane | 15) - c1s); }
        asm volatile("s_waitcnt lgkmcnt(0)" ::: "memory");
        __syncthreads();
        asm volatile("s_waitcnt vmcnt(0)" : "+v"(zq[0]), "+v"(zq[1]), "+v"(zq[2]), "+v"(zq[3]), "+v"(xn[0]), "+v"(xn[1]) :: "memory");
        { GAS char* yb = (GAS char*)(YG + row0 * DM) + (unsigned)((16 * w + fr) * DM + h * 64 + 4 * g4) * 2u;
#pragma unroll
          for (int pt = 0; pt < 4; ++pt) {
            const float xx[4] = {bf_lo(xq[pt].x), bf_hi(xq[pt].x), bf_lo(xq[pt].y), bf_hi(xq[pt].y)}, zz[4] = {bf_lo(zq[pt].x), bf_hi(zq[pt].x), bf_lo(zq[pt].y), bf_hi(zq[pt].y)};
            float yo[4];
#pragma unroll
            for (int r = 0; r < 4; ++r) { const float y = yacc[pt][r] + el * oacc[pt][r] + xx[r] * skip; yo[r] = y * silu_f(zz[r]); }
            u32x2 ow; ow.x = cvt_pk_bf16(yo[0], yo[1]); ow.y = cvt_pk_bf16(yo[2], yo[3]);
            *(GAS u32x2*)(yb + 32 * pt) = ow;
          } }
        xr[0] = xn[0]; xr[1] = xn[1]; d0 = dn0; d1 = dn1;
    }
    asm volatile("s_waitcnt vmcnt(0)" ::: "memory");
    GAS float* pssm = (GAS float*)(A.out + O_PSSM);
#pragma unroll
    for (int pt = 0; pt < 4; ++pt)
#pragma unroll
        for (int r = 0; r < 4; ++r) pssm[((size_t)(b * 32 + h) * 64 + 16 * pt + 4 * g4 + r) * 128 + 16 * w + fr] = sacc[pt][r];
#undef SSD_FRAG
#undef SSD_STAGE_B
#undef SSD_STAGE_C
}

__device__ __forceinline__ void ssd_decode_task(const Ctx& X, const Args& A, int task) {
    unsigned char* const wsl = fresh_ws(A);
    const int lane = X.lane, b = task >> 7, h = (task >> 2) & 31, pq = task & 3, gi = h >> 2;
    const int p = pq * 16 + (lane >> 2), nq = lane & 3;
    const GAS bf16_t* proj = (const GAS bf16_t*)(wsl + WS_PROJ); const GAS bf16_t* XB = (const GAS bf16_t*)(wsl + WS_XBCA); const GAS float* DT = (const GAS float*)(wsl + WS_DT); GAS bf16_t* YG = (GAS bf16_t*)(wsl + WS_YG);
    const float A_h = -expf(((const GAS float*)A.in[17])[h]), Dh = ((const GAS float*)A.in[18])[h];
    const GAS f32x4* sp = (const GAS f32x4*)((const GAS float*)A.in[6] + ((size_t)(b * 32 + h) * 64 + p) * 128 + nq * 32);
    LAS unsigned char* wl = X.lds + X.wave * 4096;
    u32x4 pc[4];
#pragma unroll
    for (int j = 0; j < 4; ++j) { const int piece = lane + 64 * j, t = piece >> 5, which = (piece >> 4) & 1, chunk = piece & 15;
        pc[j] = *(const GAS u32x4*)(XB + (size_t)(MP + b * 8 + t) * 4096 + 2048 + which * 1024 + gi * 128 + chunk * 8); }
    float dtv[8], xv[8], zv[8];
#pragma unroll
    for (int t = 0; t < 8; ++t) { const size_t row = (size_t)(MP + b * 8 + t);
        dtv[t] = DT[row * 32 + h]; xv[t] = bf2f(XB[row * 4096 + h * 64 + p]); zv[t] = bf2f(proj[row * NP + C_ZB + h * 64 + p]); }
    float st[32];
#pragma unroll
    for (int i = 0; i < 8; ++i) { const f32x4 v = sp[i]; st[4 * i] = v[0]; st[4 * i + 1] = v[1]; st[4 * i + 2] = v[2]; st[4 * i + 3] = v[3]; }
#pragma unroll
    for (int j = 0; j < 4; ++j) *(LAS u32x4*)(wl + (lane + 64 * j) * 16) = pc[j];
#pragma unroll
    for (int t = 0; t < 8; ++t) {
        const size_t row = (size_t)(MP + b * 8 + t);
        const float dt = dtv[t], dA = __expf(dt * A_h), xx = xv[t], xdt = xx * dt;
        float dot = 0.f;
#pragma unroll
        for (int i = 0; i < 4; ++i) { float bb[8], cv[8]; unpack8(*(const LAS u32x4*)(wl + (32 * t + nq * 4 + i) * 16), bb); unpack8(*(const LAS u32x4*)(wl + (32 * t + 16 + nq * 4 + i) * 16), cv);
#pragma unroll
            for (int e = 0; e < 8; ++e) { st[8 * i + e] = st[8 * i + e] * dA + xdt * bb[e]; dot += st[8 * i + e] * cv[e]; } }
        dot += __shfl_xor(dot, 1); dot += __shfl_xor(dot, 2);
        if (nq == 0) YG[row * DM + h * 64 + p] = f2bf((dot + xx * Dh) * silu_f(zv[t]));
    }
    GAS f32x4* op = (GAS f32x4*)(A.out + O_SSSM + ((size_t)(b * 32 + h) * 64 + p) * 128 + nq * 32);
#pragma unroll
    for (int i = 0; i < 8; ++i) op[i] = (f32x4){st[4 * i], st[4 * i + 1], st[4 * i + 2], st[4 * i + 3]};
}

constexpr int A_K = 0, A_V = 73728;
struct AttnItem { const GAS bf16_t* kc; const GAS bf16_t* vc; int m0; };
__device__ __forceinline__ AttnItem attn_item(const Args& A, int it) {
    const int g = it >> 10, rem = it & 1023, dsh = 2 * g, d = 1 << dsh, nqbsh = 5 - dsh;
    const int qb = rem & ((1 << nqbsh) - 1), rr = (rem >> nqbsh) & (d - 1), bh = rem >> (nqbsh + dsh), b = bh >> 3, h = bh & 7;
    const GAS bf16_t* kvc = (const GAS bf16_t*)(A.ws + WS_KVC);
    AttnItem N; N.m0 = 128 * qb - 144;
    N.kc = kvc + ((size_t)(((0 * 3 + g) * 4 + b) * 8 + h) << 19) + ((size_t)rr << (12 - dsh)) * 128;
    N.vc = kvc + ((size_t)(((1 * 3 + g) * 4 + b) * 8 + h) << 19) + ((size_t)rr << (12 - dsh)) * 128;
    return N;
}
__device__ __forceinline__ void attn_load_piece(const Ctx& X, const AttnItem& N, int i, u32x4& v, unsigned& zmask) {
    int idx = X.tid + 512 * i; if (idx >= (256 + 272) * 16) idx -= 4096;
    const int ch = idx & 15; int r = idx >> 4; const bool isv = r >= 256; if (isv) r -= 256;
    const int m = N.m0 + (isv ? r : r + 16);
    if (m < 0) zmask |= 1u << i;
    v = *(const GAS u32x4*)((isv ? N.vc : N.kc) + (m < 0 ? 0 : m) * 128 + ch * 8);
}
__device__ __forceinline__ unsigned attn_load(const Ctx& X, const Args& A, int it, u32x4 (&v)[17]) {
    const AttnItem N = attn_item(A, it);
    unsigned zmask = 0u;
#pragma unroll
    for (int i = 0; i < 17; ++i) attn_load_piece(X, N, i, v[i], zmask);
    return zmask;
}
__device__ __forceinline__ void attn_store(const Ctx& X, const u32x4 (&v)[17], unsigned zmask) {
#pragma unroll
    for (int i = 0; i < 17; ++i) {
        const int idx = X.tid + 512 * i, ch = idx & 15; int r = idx >> 4; const bool isv = r >= 256; if (isv) r -= 256;
        const u32x4 w = ((zmask >> i) & 1u) ? (u32x4){0u, 0u, 0u, 0u} : v[i];
        if (idx < (256 + 272) * 16) *(LAS u32x4*)(X.lds + (isv ? A_V : A_K) + r * 288 + ch * 16) = w;
    }
}
__device__ __forceinline__ void attn_load_q(const Ctx& X, const Args& A, int it, bf16x8 (&qf)[4]) {
    const int lane = X.lane, w = X.wave, fr = lane & 15, g4 = lane >> 4;
    const int g = it >> 10, rem = it & 1023, dsh = 2 * g, d = 1 << dsh, nqbsh = 5 - dsh;
    const int qb = rem & ((1 << nqbsh) - 1), rr = (rem >> nqbsh) & (d - 1), bh = rem >> (nqbsh + dsh), b = bh >> 3, h = bh & 7;
    const GAS bf16_t* proj = (const GAS bf16_t*)(A.ws + WS_PROJ);
    const long qrow = (long)b * 4096 + rr + (long)(128 * qb + 16 * w + fr) * d;
#pragma unroll
    for (int ks = 0; ks < 4; ++ks) qf[ks] = *(const GAS bf16x8*)(proj + qrow * NP + C_Q + g * 1024 + h * 128 + 32 * ks + 8 * g4);
}
__device__ __forceinline__ unsigned attn_prompt_compute(const Ctx& X, const Args& A, int it, const bf16x8 (&qf)[4], int nxt, bf16x8 (&qn)[4], u32x4 (&kv)[17], unsigned* ctr, unsigned& fut) {
    unsigned char* const wsl = fresh_ws(A);
    LAS unsigned char* lds = X.lds;
    const int lane = X.lane, w = X.wave, fr = lane & 15, g4 = lane >> 4;
    const int g = it >> 10, rem = it & 1023, dsh = 2 * g, d = 1 << dsh, nqbsh = 5 - dsh;
    const int qb = rem & ((1 << nqbsh) - 1), rr = (rem >> nqbsh) & (d - 1), bh = rem >> (nqbsh + dsh), b = bh >> 3, h = bh & 7;
    const GAS bf16_t* proj = (const GAS bf16_t*)(wsl + WS_PROJ);
    GAS bf16_t* OG = (GAS bf16_t*)(wsl + WS_OG) + (size_t)g * MT * 1024; GAS float* LSE = (GAS float*)(wsl + WS_LSE) + (size_t)g * MT * 8;
    const long rowb = (long)b * 4096 + rr;
    const int m0 = 128 * qb - 144;
    const int hc = g * 1024 + h * 128;
    const int mq = 128 * qb + 16 * w + fr;
    const long qrow = rowb + (long)mq * d;
    const AttnItem NI = attn_item(A, nxt); unsigned zmn = 0u;
    attn_load_q(X, A, nxt, qn);
    f32x4 sc[9];
#pragma unroll
    for (int kt = 1; kt <= 9; ++kt) {
        f32x4 acc = (f32x4){0.f, 0.f, 0.f, 0.f};
        const int krow = 16 * w + 16 * kt - 16 + fr;
#pragma unroll
        for (int ks = 0; ks < 4; ++ks) acc = MFMA16(*(const LAS bf16x8*)(lds + A_K + krow * 288 + (32 * ks + 8 * g4) * 2), qf[ks], acc);
        sc[kt - 1] = acc;
        attn_load_piece(X, NI, kt - 1, kv[kt - 1], zmn);
    }
    const float NEG = -__builtin_inff();
#pragma unroll
    for (int r = 0; r < 4; ++r) { if (4 * g4 + r < fr) sc[0][r] = NEG; if (4 * g4 + r > fr) sc[8][r] = NEG; }
    if (qb == 0) {
#pragma unroll
        for (int kt = 1; kt <= 9; ++kt)
#pragma unroll
            for (int r = 0; r < 4; ++r) if (m0 + 16 * w + 16 * kt + 4 * g4 + r < 0) sc[kt - 1][r] = NEG;
    }
    float mx = sc[0][0];
#pragma unroll
    for (int kt = 0; kt < 9; ++kt)
#pragma unroll
        for (int r = 0; r < 4; ++r) mx = fmaxf(mx, sc[kt][r]);
    mx = fmaxf(mx, __shfl_xor(mx, 16)); mx = fmaxf(mx, __shfl_xor(mx, 32));
    const float c2 = ATT_SCALE * 1.4426950408889634f;
    float l = 0.f;
#pragma unroll
    for (int kt = 0; kt < 9; ++kt)
#pragma unroll
        for (int r = 0; r < 4; ++r) { const float p = __builtin_amdgcn_exp2f((sc[kt][r] - mx) * c2); sc[kt][r] = p; l += p; }
    l += __shfl_xor(l, 16); l += __shfl_xor(l, 32);
    bf16x8 pf[5];
    pf[0] = cat8((s16x4){0, 0, 0, 0}, pack4(sc[0][0], sc[0][1], sc[0][2], sc[0][3]));
#pragma unroll
    for (int j = 1; j < 5; ++j) pf[j] = cat8(pack4(sc[2 * j - 1][0], sc[2 * j - 1][1], sc[2 * j - 1][2], sc[2 * j - 1][3]), pack4(sc[2 * j][0], sc[2 * j][1], sc[2 * j][2], sc[2 * j][3]));
    f32x4 oacc[8];
#pragma unroll
    for (int dt = 0; dt < 8; ++dt) oacc[dt] = (f32x4){0.f, 0.f, 0.f, 0.f};
    const int q = fr >> 2, pp = fr & 3;
#pragma unroll
    for (int j = 0; j < 5; ++j) {
        const int r0 = 16 * w + 32 * j + 4 * g4 + q;
        s16x4 a0[8], a1[8];
#pragma unroll
        for (int dt = 0; dt < 8; ++dt) { a0[dt] = vtr(lds + A_V + r0 * 288 + (16 * dt + 4 * pp) * 2); a1[dt] = vtr(lds + A_V + (r0 + 16) * 288 + (16 * dt + 4 * pp) * 2); }
        __builtin_amdgcn_sched_barrier(0);
#pragma unroll
        for (int dt = 0; dt < 8; ++dt) oacc[dt] = MFMA16(cat8(a0[dt], a1[dt]), pf[j], oacc[dt]);
        if (j < 4) { attn_load_piece(X, NI, 9 + 2 * j, kv[9 + 2 * j], zmn); attn_load_piece(X, NI, 10 + 2 * j, kv[10 + 2 * j], zmn); }
        if (j == 3 && X.tid == 0) asm volatile("global_atomic_add %0, %1, %2, %3 sc0" : "=v"(fut) : "v"(0u), "v"(1u), "s"(ctr) : "memory");
        __builtin_amdgcn_sched_barrier(0);
    }
    const float inv = 1.f / l;
#pragma unroll
    for (int dt = 0; dt < 8; ++dt) { u32x2 ow; ow.x = cvt_pk_bf16(oacc[dt][0] * inv, oacc[dt][1] * inv); ow.y = cvt_pk_bf16(oacc[dt][2] * inv, oacc[dt][3] * inv);
        *(GAS u32x2*)(OG + qrow * 1024 + h * 128 + 16 * dt + 4 * g4) = ow; }
    if (g4 == 0) LSE[qrow * 8 + h] = mx * ATT_SCALE + __logf(l);
    return zmn;
}

__device__ __forceinline__ void attn_decode_item(const Ctx& X, const Args& A, int it) {
    unsigned char* const wsl = fresh_ws(A);
    const int lane = X.lane, t = X.wave, hh = lane >> 5, l32 = lane & 31;
    const int g = it >> 8, b = (it >> 3) & 31, h = it & 7, wb = 128 << (2 * g), d = 1 << (2 * g);
    const GAS bf16_t* proj = (const GAS bf16_t*)(wsl + WS_PROJ);
    const GAS float* cache = (const GAS float*)A.in[2 + g];
    GAS bf16_t* OG = (GAS bf16_t*)(wsl + WS_OG) + (size_t)g * MT * 1024; GAS float* LSE = (GAS float*)(wsl + WS_LSE) + (size_t)g * MT * 8;
    const int hc = g * 1024 + h * 128 + 4 * l32;
    const size_t qrow = (size_t)(MP + b * 8 + t);
    const u32x2 qq = *(const GAS u32x2*)(proj + qrow * NP + C_Q + hc);
    const float q0 = bf_lo(qq.x) * ATT_SCALE, q1 = bf_hi(qq.x) * ATT_SCALE, q2 = bf_lo(qq.y) * ATT_SCALE, q3 = bf_hi(qq.y) * ATT_SCALE;
    float m = -1e30f, l = 0.f, o0 = 0.f, o1 = 0.f, o2 = 0.f, o3 = 0.f;
#define DEC_KEY(kk, vq, ok) do { float s_ = (q0 * (kk)[0] + q1 * (kk)[1]) + (q2 * (kk)[2] + q3 * (kk)[3]); \
        s_ += __shfl_xor(s_, 1); s_ += __shfl_xor(s_, 2); s_ += __shfl_xor(s_, 4); s_ += __shfl_xor(s_, 8); s_ += __shfl_xor(s_, 16); \
        if (ok) { const float mn_ = fmaxf(m, s_), al_ = __expf(m - mn_), p_ = __expf(s_ - mn_); \
            l = l * al_ + p_; o0 = o0 * al_ + p_ * (vq)[0]; o1 = o1 * al_ + p_ * (vq)[1]; o2 = o2 * al_ + p_ * (vq)[2]; o3 = o3 * al_ + p_ * (vq)[3]; m = mn_; } } while (0)
    const int jn = t / d + 1;
    { u32x2 k2[4], v2[4];
#pragma unroll
      for (int i = 0; i < 4; ++i) { const int j = 2 * i + hh, jc = j < jn ? j : 0; const size_t r = (size_t)(MP + b * 8 + (t - jc * d));
          k2[i] = *(const GAS u32x2*)(proj + r * NP + C_K + hc); v2[i] = *(const GAS u32x2*)(proj + r * NP + C_V + hc); }
#pragma unroll
      for (int i = 0; i < 4; ++i) { const int j = 2 * i + hh;
          const f32x4 kk = (f32x4){bf_lo(k2[i].x), bf_hi(k2[i].x), bf_lo(k2[i].y), bf_hi(k2[i].y)}, vq = (f32x4){bf_lo(v2[i].x), bf_hi(v2[i].x), bf_lo(v2[i].y), bf_hi(v2[i].y)};
          DEC_KEY(kk, vq, j < jn); } }
    const GAS float* cbase = cache + (size_t)b * wb * 2048 + h * 128 + 4 * l32;
    for (int i0 = 0; jn + 2 * i0 <= 128; i0 += 8) {
        f32x4 kv[8], vv[8];
#pragma unroll
        for (int u = 0; u < 8; ++u) {
            int j = jn + 2 * (i0 + u) + hh; if (j > 128) j = 128;
            const GAS float* p = cbase + (size_t)(wb + t - j * d) * 2048; kv[u] = *(const GAS f32x4*)p; vv[u] = *(const GAS f32x4*)(p + 1024);
        }
#pragma unroll
        for (int u = 0; u < 8; ++u) { const int j = jn + 2 * (i0 + u) + hh; DEC_KEY(kv[u], vv[u], j <= 128); }
    }
#undef DEC_KEY
    const float m2 = __shfl_xor(m, 32), mm = fmaxf(m, m2), a1 = __expf(m - mm);
    l *= a1; o0 *= a1; o1 *= a1; o2 *= a1; o3 *= a1;
    l += __shfl_xor(l, 32); o0 += __shfl_xor(o0, 32); o1 += __shfl_xor(o1, 32); o2 += __shfl_xor(o2, 32); o3 += __shfl_xor(o3, 32);
    const float inv = 1.f / l;
    if (hh == 0) { u32x2 ow; ow.x = cvt_pk_bf16(o0 * inv, o1 * inv); ow.y = cvt_pk_bf16(o2 * inv, o3 * inv); *(GAS u32x2*)(OG + qrow * 1024 + h * 128 + 4 * l32) = ow; }
    if (lane == 0) LSE[qrow * 8 + h] = mm + __logf(l);
}

__device__ __forceinline__ void cvt8_store(const GAS bf16_t* s, GAS float* dptr) {
    const u32x4 v = *(const GAS u32x4*)s;
    __builtin_nontemporal_store((f32x4){bf_lo(v.x), bf_hi(v.x), bf_lo(v.y), bf_hi(v.y)}, (GAS f32x4*)dptr);
    __builtin_nontemporal_store((f32x4){bf_lo(v.z), bf_hi(v.z), bf_lo(v.w), bf_hi(v.w)}, (GAS f32x4*)(dptr + 4));
}
__device__ __forceinline__ void extract_outputs(const Ctx& X, const Args& A) {
    unsigned char* const wsl = fresh_ws(A);
    const GAS bf16_t* proj = (const GAS bf16_t*)(wsl + WS_PROJ); const GAS bf16_t* kvc = (const GAS bf16_t*)(wsl + WS_KVC);
    const size_t gt = (size_t)X.bid * 512 + X.tid, GT = (size_t)X.G * 512;
#pragma unroll
    for (int g = 0; g < 3; ++g) {
        const int W = 128 << (2 * g);
        GAS float* po = (GAS float*)(A.out + (g == 0 ? O_PKV128 : g == 1 ? O_PKV512 : O_PKV2048));
        const size_t tot = (size_t)4 * W * 2 * 128;
        const int U = g == 0 ? 1 : (g == 1 ? 4 : 8);
        for (size_t i0 = gt; i0 < tot; i0 += GT * U) {
            u32x4 v[8];
#pragma unroll
            for (int q = 0; q < U; ++q) { size_t i = i0 + (size_t)q * GT; if (i >= tot) i = gt;
                const int u = (int)(i & 127), kv = (int)((i >> 7) & 1); const size_t bj = i >> 8; const int j = (int)(bj % W), b = (int)(bj / W);
                const int t = 4096 - W + j, ridx = ((t & ((1 << (2 * g)) - 1)) << (12 - 2 * g)) + (t >> (2 * g));
                v[q] = *(const GAS u32x4*)(kvc + ((size_t)((((kv * 3 + g) * 4 + b) * 8) + (u >> 4)) << 19) + (size_t)ridx * 128 + (u & 15) * 8); }
#pragma unroll
            for (int q = 0; q < U; ++q) { const size_t i = i0 + (size_t)q * GT;
                if (i < tot) { GAS float* dptr = po + i * 8;
                    __builtin_nontemporal_store((f32x4){bf_lo(v[q].x), bf_hi(v[q].x), bf_lo(v[q].y), bf_hi(v[q].y)}, (GAS f32x4*)dptr);
                    __builtin_nontemporal_store((f32x4){bf_lo(v[q].z), bf_hi(v[q].z), bf_lo(v[q].w), bf_hi(v[q].w)}, (GAS f32x4*)(dptr + 4)); } }
        }
        GAS float* so = (GAS float*)(A.out + (g == 0 ? O_SKV128 : g == 1 ? O_SKV512 : O_SKV2048));
        const size_t tot2 = (size_t)32 * 8 * 2 * 128;
        for (size_t i = gt; i < tot2; i += GT) { const int u = (int)(i & 127), kv = (int)((i >> 7) & 1); const int t = (int)((i >> 8) & 7), b = (int)(i >> 11);
            cvt8_store(proj + ((size_t)MP + b * 8 + t) * NP + (kv ? C_V : C_K) + g * 1024 + u * 8, so + (((size_t)b * W + (W - 8 + t)) * 2 + kv) * 1024 + u * 8); }
    }
    GAS float* pc = (GAS float*)(A.out + O_PCONV); GAS float* scv = (GAS float*)(A.out + O_SCONV);
    for (size_t i = gt; i < (size_t)4 * 3 * 512; i += GT) { const int u = (int)(i & 511), j = (int)((i >> 9) % 3), b = (int)(i / 1536);
        cvt8_store(proj + ((size_t)b * 4096 + 4093 + j) * NP + C_XBC + u * 8, pc + i * 8); }
    for (size_t i = gt; i < (size_t)32 * 3 * 512; i += GT) { const int u = (int)(i & 511), j = (int)((i >> 9) % 3), b = (int)(i / 1536);
        cvt8_store(proj + ((size_t)MP + b * 8 + 5 + j) * NP + C_XBC + u * 8, scv + i * 8); }
}

__device__ __forceinline__ void phase3(const Ctx& X, const Args& A) {
    conv_prepass(X, A);
    for (int it = X.bid; it < 768 * REP_DEC; it += X.G) attn_decode_item(X, A, it % 768);
    extract_outputs(X, A);
#if REP_DEC > 1
    extract_outputs(X, A);
#endif
}
constexpr int CW_QATT = 8192;
__device__ __forceinline__ int att_next(const Ctx& X, const Args& A) {
    volatile LAS unsigned* MISC = (volatile LAS unsigned*)(X.lds + MISC_OFF);
    if (X.tid == 0) MISC[16] = __hip_atomic_fetch_add((unsigned*)(A.ws + WS_CTL) + CW_QATT, 1u, __ATOMIC_RELAXED, __HIP_MEMORY_SCOPE_AGENT);
    __syncthreads();
    const int v = (int)MISC[16];
    __syncthreads();
    return v;
}
__device__ __forceinline__ void phase3b(const Ctx& X, const Args& A) {
    for (int it = X.bid; it < 128 * REP_SSD; it += X.G) { const int i = it & 127, xcd = i & 7, slot = i >> 3, grp = xcd * 4 + (slot >> 2);
        ssd_prompt_item64(X, A, grp >> 3, (grp & 7) * 4 + (slot & 3)); }
    {
        constexpr int NATT = 3072 * REP_ATT;
        volatile LAS unsigned* MISC = (volatile LAS unsigned*)(X.lds + MISC_OFF);
        unsigned* const ctr = (unsigned*)(A.ws + WS_CTL) + CW_QATT;
        u32x4 kv[17]; unsigned zm = 0u, fut = 0u;
        if (X.tid == 0) MISC[16] = __hip_atomic_fetch_add(ctr, 2u, __ATOMIC_RELAXED, __HIP_MEMORY_SCOPE_AGENT);
        __syncthreads();
        int it = (int)MISC[16], nx = it + 1;
        if (X.tid == 0) asm volatile("global_atomic_add %0, %1, %2, %3 sc0" : "=v"(fut) : "v"(0u), "v"(1u), "s"(ctr) : "memory");
        bf16x8 qf[4];
        if (it < NATT) { attn_load_q(X, A, it % 3072, qf); zm = attn_load(X, A, it % 3072, kv); }
        while (it < NATT) {
            attn_store(X, kv, zm);
            if (X.tid == 0) { asm volatile("s_waitcnt vmcnt(0)" : "+v"(fut) :: "memory"); MISC[16] = fut; }
            const int pn = (nx < NATT ? nx : it) % 3072;
            bf16x8 qn[4];
            __syncthreads();
            zm = attn_prompt_compute(X, A, it % 3072, qf, pn, qn, kv, ctr, fut);
#pragma unroll
            for (int ks = 0; ks < 4; ++ks) qf[ks] = qn[ks];
            __syncthreads();
            it = nx; nx = (int)MISC[16];
        }
        if (X.tid == 0) asm volatile("s_waitcnt vmcnt(0)" : "+v"(fut) :: "memory");
    }
    for (int task = X.bid * 8 + X.wave; task < 4096 * REP_DEC; task += X.G * 8) ssd_decode_task(X, A, task & 4095);
}

__device__ __forceinline__ void phase4(const Ctx& X, const Args& A) {
    unsigned char* const wsl = fresh_ws(A);
    const GAS bf16_t* proj = (const GAS bf16_t*)(wsl + WS_PROJ); const GAS bf16_t* OG = (const GAS bf16_t*)(wsl + WS_OG); const GAS float* LSE = (const GAS float*)(wsl + WS_LSE);
    const GAS bf16_t* YG = (const GAS bf16_t*)(wsl + WS_YG); GAS bf16_t* AY = (GAS bf16_t*)(wsl + WS_AY); const GAS float* gssm = (const GAS float*)A.in[19];
    const int gw = X.bid * 8 + X.wave, NGW = X.G * 8, lane = X.lane;
    for (int m = gw; m < MT; m += NGW) {
        u32x4 yv[4];
        { const GAS u32x4* yp = (const GAS u32x4*)(YG + (size_t)m * DM + 32 * lane);
#pragma unroll
          for (int q = 0; q < 4; ++q) yv[q] = yp[q]; }
        __builtin_amdgcn_sched_barrier(0);
        {
            const int hd = lane >> 3;
            const float l0 = LSE[(size_t)m * 8 + hd], l1 = LSE[((size_t)MT + m) * 8 + hd], l2 = LSE[((size_t)2 * MT + m) * 8 + hd];
            const float mx = fmaxf(l0, fmaxf(l1, l2)); float w0 = __expf(l0 - mx), w1 = __expf(l1 - mx), w2 = __expf(l2 - mx); const float inv = 1.f / (w0 + w1 + w2); w0 *= inv; w1 *= inv; w2 *= inv;
            float o[16];
#pragma unroll
            for (int e = 0; e < 16; ++e) o[e] = 0.f;
#pragma unroll
            for (int g = 0; g < 3; ++g) { const float wg = g == 0 ? w0 : (g == 1 ? w1 : w2);
                const GAS u32x4* p = (const GAS u32x4*)(OG + ((size_t)g * MT + m) * 1024 + 16 * lane);
#pragma unroll
                for (int q = 0; q < 2; ++q) { const u32x4 v = p[q];
                    o[8 * q + 0] += wg * bf_lo(v.x); o[8 * q + 1] += wg * bf_hi(v.x); o[8 * q + 2] += wg * bf_lo(v.y); o[8 * q + 3] += wg * bf_hi(v.y);
                    o[8 * q + 4] += wg * bf_lo(v.z); o[8 * q + 5] += wg * bf_hi(v.z); o[8 * q + 6] += wg * bf_lo(v.w); o[8 * q + 7] += wg * bf_hi(v.w); } }
            const GAS u32x4* zp = (const GAS u32x4*)(proj + (size_t)m * NP + C_ZA + 16 * lane);
            GAS u32x4* op = (GAS u32x4*)(AY + (size_t)m * KAB + 16 * lane);
#pragma unroll
            for (int q = 0; q < 2; ++q) { const u32x4 z = zp[q]; u32x4 w;
                w.x = cvt_pk_bf16(o[8 * q + 0] * silu_f(bf_lo(z.x)), o[8 * q + 1] * silu_f(bf_hi(z.x))); w.y = cvt_pk_bf16(o[8 * q + 2] * silu_f(bf_lo(z.y)), o[8 * q + 3] * silu_f(bf_hi(z.y)));
                w.z = cvt_pk_bf16(o[8 * q + 4] * silu_f(bf_lo(z.z)), o[8 * q + 5] * silu_f(bf_hi(z.z))); w.w = cvt_pk_bf16(o[8 * q + 6] * silu_f(bf_lo(z.w)), o[8 * q + 7] * silu_f(bf_hi(z.w)));
                op[q] = w; }
        }
        {
            float y[32]; float ss = 0.f;
#pragma unroll
            for (int q = 0; q < 4; ++q) { const u32x4 v = yv[q];
                y[8 * q + 0] = bf_lo(v.x); y[8 * q + 1] = bf_hi(v.x); y[8 * q + 2] = bf_lo(v.y); y[8 * q + 3] = bf_hi(v.y); y[8 * q + 4] = bf_lo(v.z); y[8 * q + 5] = bf_hi(v.z); y[8 * q + 6] = bf_lo(v.w); y[8 * q + 7] = bf_hi(v.w); }
#pragma unroll
            for (int e = 0; e < 32; ++e) ss += y[e] * y[e];
            ss += __shfl_xor(ss, 1); ss += __shfl_xor(ss, 2); ss += __shfl_xor(ss, 4);
            const float rs = rsqrtf(ss * (1.f / 256.f) + NORM_EPS);
            const GAS f32x4* gp = (const GAS f32x4*)(gssm + 32 * lane);
            GAS u32x4* op = (GAS u32x4*)(AY + (size_t)m * KAB + 1024 + 32 * lane);
#pragma unroll
            for (int q = 0; q < 4; ++q) { const f32x4 ga = gp[2 * q], gb = gp[2 * q + 1]; u32x4 w;
                w.x = cvt_pk_bf16(y[8 * q + 0] * rs * ga[0], y[8 * q + 1] * rs * ga[1]); w.y = cvt_pk_bf16(y[8 * q + 2] * rs * ga[2], y[8 * q + 3] * rs * ga[3]);
                w.z = cvt_pk_bf16(y[8 * q + 4] * rs * gb[0], y[8 * q + 5] * rs * gb[1]); w.w = cvt_pk_bf16(y[8 * q + 6] * rs * gb[2], y[8 * q + 7] * rs * gb[3]);
                op[q] = w; }
        }
    }
}

template <int KSTEPS> __device__ __forceinline__ f32x4 skinny_acc(const GAS bf16_t* arow, const GAS bf16_t* brow) {
    f32x4 acc = (f32x4){0.f, 0.f, 0.f, 0.f};
#pragma unroll
    for (int k0 = 0; k0 < KSTEPS; k0 += 16) {
        bf16x8 a[16], b[16];
#pragma unroll
        for (int u = 0; u < 16; ++u) { a[u] = *(const GAS bf16x8*)(arow + (k0 + u) * 32); b[u] = *(const GAS bf16x8*)(brow + (k0 + u) * 32); }
        __builtin_amdgcn_sched_barrier(0);
#pragma unroll
        for (int u = 0; u < 16; ++u) acc = MFMA16(a[u], b[u], acc);
        __builtin_amdgcn_sched_barrier(0);
    }
    return acc;
}
__device__ __forceinline__ void decode_merge(GAS unsigned char* wsg, int bid, int G) {
    const GAS bf16_t* AY = (const GAS bf16_t*)(wsg + WS_AY); const GAS bf16_t* WAB = (const GAS bf16_t*)(wsg + WS_WAB); const GAS bf16_t* proj = (const GAS bf16_t*)(wsg + WS_PROJ); GAS bf16_t* MRG = (GAS bf16_t*)(wsg + WS_MRG);
    const int lane = threadIdx.x & 63, wave = threadIdx.x >> 6, fr = lane & 15, g4 = lane >> 4;
    for (int it = bid; it < 256; it += G) {
        const int c0 = (it & 31) * 64 + (wave & 3) * 16, r0 = MP + (it >> 5) * 32 + (wave >> 2) * 16;
        const GAS bf16_t* ar = AY + (size_t)(r0 + fr) * KAB + 8 * g4; const GAS bf16_t* br = WAB + (size_t)(c0 + fr) * KAB + 8 * g4;
        const f32x4 pa = skinny_acc<32>(ar, br), pb = skinny_acc<64>(ar + 1024, br + 1024);
#pragma unroll
        for (int r = 0; r < 4; ++r) { const size_t row = (size_t)(r0 + 4 * g4 + r); const int col = c0 + fr;
            const float ga = sigmoid_f(bf2f(proj[row * NP + C_RA + col])), gb = sigmoid_f(bf2f(proj[row * NP + C_RB + col]));
            MRG[row * DM + col] = f2bf(ga * pa[r] + gb * pb[r]); }
    }
}
__device__ __forceinline__ void decode_out(GAS unsigned char* wsg, int bid, int G) {
    const GAS bf16_t* MRG = (const GAS bf16_t*)(wsg + WS_MRG); const GAS bf16_t* WO = (const GAS bf16_t*)(wsg + WS_WO); GAS float* OUT = (GAS float*)(wsg + WS_OUTD);
    const int lane = threadIdx.x & 63, wave = threadIdx.x >> 6, fr = lane & 15, g4 = lane >> 4;
    for (int it = bid; it < 256; it += G) {
        const int c0 = (it & 31) * 64 + (wave & 3) * 16, r0 = MP + (it >> 5) * 32 + (wave >> 2) * 16;
        const f32x4 acc = skinny_acc<64>(MRG + (size_t)(r0 + fr) * DM + 8 * g4, WO + (size_t)(c0 + fr) * DM + 8 * g4);
#pragma unroll
        for (int r = 0; r < 4; ++r) OUT[(size_t)(r0 - MP + 4 * g4 + r) * DM + c0 + fr] = acc[r];
    }
}

template <bool BF> __device__ __forceinline__ void final_row(const GAS void* orow_, const GAS f32x4* xr, const GAS f32x4* gt4, const GAS f32x4* g4, GAS f32x4* o, int lane) {
    f32x4 v[8], xv[8]; float ss = 0.f;
#pragma unroll
    for (int j = 0; j < 8; ++j) xv[j] = __builtin_nontemporal_load(xr + lane + 64 * j);
    f32x4 ggv[8], gtv[8];
#pragma unroll
    for (int j = 0; j < 8; ++j) { ggv[j] = g4[lane + 64 * j]; gtv[j] = gt4[lane + 64 * j]; }
#pragma unroll
    for (int j = 0; j < 8; ++j) {
        if constexpr (BF) { const u32x2 q = __builtin_nontemporal_load((const GAS u32x2*)orow_ + lane + 64 * j); v[j] = (f32x4){bf_lo(q.x), bf_hi(q.x), bf_lo(q.y), bf_hi(q.y)}; }
        else v[j] = ((const GAS f32x4*)orow_)[lane + 64 * j]; }
    __builtin_amdgcn_sched_barrier(0);
#pragma unroll
    for (int j = 0; j < 8; ++j) {
        ss += (v[j][0] * v[j][0] + v[j][1] * v[j][1]) + (v[j][2] * v[j][2] + v[j][3] * v[j][3]); }
    const float rstd = rsqrtf(wave_sum(ss) * (1.f / DM) + NORM_EPS);
#pragma unroll
    for (int j = 0; j < 8; ++j) { const f32x4 gg = ggv[j], gt = gtv[j], xx = xv[j];
        f32x4 y;
#pragma unroll
        for (int e = 0; e < 4; ++e) y[e] = xx[e] + gt[e] * (v[j][e] * rstd * gg[e]);
        __builtin_nontemporal_store(y, o + lane + 64 * j); }
}
__device__ __forceinline__ void phase7(const Ctx& X, const Args& A) {
    unsigned char* const wsl = fresh_ws(A);
    const GAS float* xp = (const GAS float*)A.in[0]; const GAS float* xs = (const GAS float*)A.in[1]; const GAS f32x4* g4 = (const GAS f32x4*)A.in[12];
    const GAS float* mod = (const GAS float*)(wsl + WS_MOD); const GAS bf16_t* OUT = (const GAS bf16_t*)(wsl + WS_OUT); const GAS float* OUTD = (const GAS float*)(wsl + WS_OUTD);
    const int gw = X.bid * 8 + X.wave, NGW = X.G * 8, lane = X.lane;
    for (int m = gw; m < MP; m += NGW)
        final_row<true>(OUT + (size_t)m * DM, (const GAS f32x4*)(xp + (size_t)m * DM), (const GAS f32x4*)(mod + (m >> 12) * 6144 + 4096), g4, (GAS f32x4*)(A.out + (size_t)m * DM), lane);
    for (int m = gw; m < MD; m += NGW)
        final_row<false>(OUTD + (size_t)m * DM, (const GAS f32x4*)(xs + (size_t)m * DM), (const GAS f32x4*)(mod + (4 + (m >> 3)) * 6144 + 4096), g4, (GAS f32x4*)(A.out + (size_t)(MP + m) * DM), lane);
}

constexpr int NPHASES = 8;
__global__ void __launch_bounds__(512, 2) hyb_fwd(Args args) {
    extern __shared__ __attribute__((aligned(16))) unsigned char lds_raw[];
    Ctx X;
    X.lds = (LAS unsigned char*)lds_raw;
    X.tid = threadIdx.x; X.lane = X.tid & 63; X.wave = __builtin_amdgcn_readfirstlane(X.tid >> 6); X.bid = blockIdx.x; X.G = gridDim.x;
    volatile LAS unsigned* MISC = (volatile LAS unsigned*)(X.lds + MISC_OFF);
    if (X.tid < 64) MISC[X.tid] = 0u;
    __syncthreads();
    unsigned* ctl = (unsigned*)(args.ws + WS_CTL);
    XcdBarrier bar; bar.bar = ctl + CW_BAR; bar.x = 0; bar.st = nullptr;
    if (MK_N_LAUNCHES == 1) bar = xcd_barrier_post(ctl + CW_BAR, MISC + 8);
#define GRID_BAR() do { if (MK_N_LAUNCHES == 1) xcd_barrier(bar); } while (0)
    const int lo = args.ph_lo, hi = args.ph_hi;
#define IN(k) (lo <= (k) && (k) < hi)
#define BOTH(k) (IN(k) && IN((k) + 1))
#define FRESH_WS() unsigned char* ws = fresh_ws(args); (void)ws
#define DO_P0() do { phase0(X, args); if (BOTH(0)) GRID_BAR(); } while (0)
#define DO_P1() do { phase1(X, args); if (BOTH(1)) GRID_BAR(); } while (0)
#define DO_P2() do { FRESH_WS(); \
        pg8::Gemm g{(const GAS bf16_t*)(ws + WS_H), (const GAS bf16_t*)(ws + WS_WIN), MT, NP, DM, DM, DM}; pg8::StaticOrder S; S.init(MT, NP, X.G, X.bid, REP_P2); \
        pg8::EpiProj E{(GAS bf16_t*)(ws + WS_PROJ), NP, (GAS float*)(ws + WS_DT), (GAS bf16_t*)(ws + WS_KVC)}; \
        pg8::SideKvCopy side; side.init((GAS f32x4*)(ws + WS_DUMMY), args.in[2], args.in[3], args.in[4], args.out); \
        pg8::gemm_phase<pg8::EpiProj, pg8::StaticOrder, true, true, pg8::SideKvCopy>(X.lds, g, S, E, side); \
        { constexpr int kShort = (65 * 81) % 256; if (X.G == 256) { if (X.bid >= kShort) late_weight_transposes(X, args, kShort); } else late_weight_transposes(X, args, 0); } \
        if (BOTH(2)) GRID_BAR(); } while (0)
#define DO_P4() do { phase4(X, args); if (BOTH(4)) GRID_BAR(); } while (0)
#define DO_P5() do { FRESH_WS(); \
        pg8::StaticOrder S; S.init(MP, DM, X.G, X.bid, REP_P56); \
        { pg8::Gemm g{(const GAS bf16_t*)(ws + WS_AY), (const GAS bf16_t*)(ws + WS_WAB), MP, DM, 1024, KAB, KAB}; \
          pg8::EpiGateA E{(const GAS bf16_t*)(ws + WS_PROJ) + C_RA, NP, (GAS bf16_t*)(ws + WS_TMP)}; \
          pg8::gemm_phase<pg8::EpiGateA, pg8::StaticOrder, true, true>(X.lds, g, S, E); } \
        { pg8::Gemm g{(const GAS bf16_t*)(ws + WS_AY) + 1024, (const GAS bf16_t*)(ws + WS_WAB) + 1024, MP, DM, 2048, KAB, KAB}; \
          pg8::EpiGateB E{(const GAS bf16_t*)(ws + WS_PROJ) + C_RB, NP, (const GAS bf16_t*)(ws + WS_TMP), (GAS bf16_t*)(ws + WS_MRG)}; \
          pg8::gemm_phase<pg8::EpiGateB, pg8::StaticOrder, true, true>(X.lds, g, S, E); } \
        decode_merge((GAS unsigned char*)ws, X.bid, X.G); \
        if (BOTH(5)) GRID_BAR(); } while (0)
#define DO_P6() do { FRESH_WS(); \
        pg8::Gemm g{(const GAS bf16_t*)(ws + WS_MRG), (const GAS bf16_t*)(ws + WS_WO), MP, DM, DM, DM, DM}; pg8::StaticOrder S; S.init(MP, DM, X.G, X.bid, REP_P56); \
        pg8::EpiOutBf16 E{(GAS bf16_t*)(ws + WS_OUT), DM}; \
        pg8::gemm_phase<pg8::EpiOutBf16, pg8::StaticOrder, true, true>(X.lds, g, S, E); \
        decode_out((GAS unsigned char*)ws, X.bid, X.G); \
        if (BOTH(6)) GRID_BAR(); } while (0)
    if (IN(0)) { DO_P0();
#if REP_P0 > 1
        DO_P0();
#endif
    }
    if (IN(1)) { DO_P1();
#if REP_LIGHT > 1
        DO_P1();
#endif
    }
    if (IN(2)) { DO_P2(); }
    if (IN(3)) { phase3(X, args); GRID_BAR(); phase3b(X, args); if (BOTH(3)) GRID_BAR(); }
    if (IN(4)) { DO_P4();
#if REP_LIGHT > 1
        DO_P4();
#endif
    }
    if (IN(5)) { DO_P5(); }
    if (IN(6)) { DO_P6(); }
    if (IN(7)) { phase7(X, args);
#if REP_LIGHT > 1
        GRID_BAR(); phase7(X, args);
#endif
    }
#undef IN
#undef BOTH
#undef GRID_BAR
}

extern "C" void kernel_launch(void* const* d_in, const int* in_sizes, int n_in, void* d_out, int out_size, void* d_ws, size_t ws_size, hipStream_t stream) {
    static int grid = 0;
    if (grid == 0) {
        if (n_in != 23 || (size_t)out_size != O_END || ws_size < WS_END) { fprintf(stderr, "kernel_launch: unexpected shapes: n_in %d out %d ws %zu\n", n_in, out_size, ws_size); grid = -1; return; }
        int dev = 0, cus = 0, per_cu = 0;
        if (hipGetDevice(&dev) != hipSuccess || hipDeviceGetAttribute(&cus, hipDeviceAttributeMultiprocessorCount, dev) != hipSuccess) { grid = -1; return; }
        if (hipFuncSetAttribute((const void*)hyb_fwd, hipFuncAttributeMaxDynamicSharedMemorySize, LDS_BYTES) != hipSuccess) { fprintf(stderr, "kernel_launch: hipFuncSetAttribute failed\n"); grid = -1; return; }
        if (hipOccupancyMaxActiveBlocksPerMultiprocessor(&per_cu, (const void*)hyb_fwd, 512, LDS_BYTES) != hipSuccess || per_cu < 1) fprintf(stderr, "kernel_launch: occupancy query reports %d\n", per_cu);
        (void)hipGetLastError();
        grid = cus;
    }
    if (grid < 0) return;
    (void)in_sizes;
    if (hipMemsetAsync((char*)d_ws + WS_CTL, 0, CTL_ZERO_BYTES, stream) != hipSuccess) return;
    Args a{};
    for (int i = 0; i < 23; ++i) a.in[i] = d_in[i];
    a.out = (float*)d_out; a.ws = (unsigned char*)d_ws;
    if (MK_N_LAUNCHES == 1) { a.ph_lo = 0; a.ph_hi = NPHASES; hipLaunchKernelGGL(hyb_fwd, dim3(grid), dim3(512), LDS_BYTES, stream, a); }
    else for (int p = 0; p < NPHASES; ++p) { a.ph_lo = p; a.ph_hi = p + 1; hipLaunchKernelGGL(hyb_fwd, dim3(grid), dim3(512), LDS_BYTES, stream, a); }
}
```

```cpp
#include <hip/hip_runtime.h>
#include <cstdio>
#include <cstdint>

#ifndef MK_N_LAUNCHES
#define MK_N_LAUNCHES 1
#endif

#ifndef REP_P0
#define REP_P0 1
#endif
#ifndef REP_P2
#define REP_P2 1
#endif
#ifndef REP_SSD
#define REP_SSD 1
#endif
#ifndef REP_ATT
#define REP_ATT 1
#endif
#ifndef REP_DEC
#define REP_DEC 1
#endif
#ifndef REP_P56
#define REP_P56 1
#endif
#ifndef REP_LIGHT
#define REP_LIGHT 1
#endif

#define GAS __attribute__((address_space(1)))
#define LAS __attribute__((address_space(3)))
typedef unsigned short bf16_t;
typedef short bf16x8 __attribute__((ext_vector_type(8)));
typedef short s16x4 __attribute__((ext_vector_type(4)));
typedef float f32x4 __attribute__((ext_vector_type(4)));
typedef float f32x2 __attribute__((ext_vector_type(2)));
typedef unsigned u32x4 __attribute__((ext_vector_type(4)));
typedef unsigned u32x2 __attribute__((ext_vector_type(2)));

constexpr int DM = 2048, MP = 16384, MD = 256, MT = MP + MD;
constexpr int NP = 20736;
constexpr int NIN = 20512;
constexpr int C_Q = 0, C_K = 3072, C_V = 6144, C_ZA = 9216, C_ZB = 10240, C_XBC = 12288, C_RA = 16384, C_RB = 18432, C_DT = 20480;
constexpr int KAB = 3072;
constexpr float ATT_SCALE = 0.08838834764831845f;
constexpr float NORM_EPS = 1e-6f;

constexpr size_t O_YP = 0, O_YS = 33554432, O_PKV128 = O_YS + 524288, O_PKV512 = O_PKV128 + 1048576, O_PKV2048 = O_PKV512 + 4194304,
                 O_PCONV = O_PKV2048 + 16777216, O_PSSM = O_PCONV + 49152, O_SKV128 = O_PSSM + 1048576, O_SKV512 = O_SKV128 + 8388608,
                 O_SKV2048 = O_SKV512 + 33554432, O_SCONV = O_SKV2048 + 134217728, O_SSSM = O_SCONV + 393216, O_END = O_SSSM + 8388608;

constexpr size_t MiB = 1u << 20;
constexpr size_t WS_CTL = 0, CTL_ZERO_BYTES = 1 * MiB;
constexpr size_t WS_MOD = 1 * MiB;
constexpr size_t WS_WIN = 2 * MiB;
constexpr size_t WS_WAB = 83 * MiB;
constexpr size_t WS_WO = 95 * MiB;
constexpr size_t WS_H = 103 * MiB;
constexpr size_t WS_DT = 168 * MiB;
constexpr size_t WS_LSE = 171 * MiB;
constexpr size_t WS_PROJ = 173 * MiB;
constexpr size_t WS_OG = 832 * MiB;
constexpr size_t WS_YG = 930 * MiB;
constexpr size_t WS_AY = 995 * MiB;
constexpr size_t WS_TMP = 1093 * MiB;
constexpr size_t WS_XBCA = WS_TMP;
constexpr size_t WS_MRG = 1223 * MiB;
constexpr size_t WS_KVC = WS_MRG;
constexpr size_t WS_OUT = 1288 * MiB;
constexpr size_t WS_OUTD = 1420 * MiB;
constexpr size_t WS_DUMMY = 1418 * MiB;
constexpr size_t WS_END = 1423 * MiB;
constexpr int CW_BAR = 4096;

constexpr int LDS_BYTES = 163840;
constexpr int MISC_OFF = 163584;

__device__ __forceinline__ unsigned cvt_pk_bf16(float lo, float hi) { unsigned r; asm volatile("v_cvt_pk_bf16_f32 %0, %1, %2" : "=v"(r) : "v"(lo), "v"(hi)); return r; }
__device__ __forceinline__ float bf_lo(unsigned w) { return __uint_as_float(w << 16); }
__device__ __forceinline__ float bf_hi(unsigned w) { return __uint_as_float(w & 0xffff0000u); }
__device__ __forceinline__ float bf2f(unsigned short b) { return __uint_as_float(((unsigned)b) << 16); }
__device__ __forceinline__ unsigned short f2bf(float f) { return (unsigned short)(cvt_pk_bf16(f, 0.f) & 0xffffu); }
__device__ __forceinline__ s16x4 pack4(float a, float b, float c, float d) { u32x2 w; w.x = cvt_pk_bf16(a, b); w.y = cvt_pk_bf16(c, d); return __builtin_bit_cast(s16x4, w); }
__device__ __forceinline__ bf16x8 cat8(s16x4 lo, s16x4 hi) { return __builtin_shufflevector(lo, hi, 0, 1, 2, 3, 4, 5, 6, 7); }
__device__ __forceinline__ float silu_f(float x) { return x * __builtin_amdgcn_rcpf(1.f + __expf(-x)); }
__device__ __forceinline__ float sigmoid_f(float x) { return __builtin_amdgcn_rcpf(1.f + __expf(-x)); }
__device__ __forceinline__ float softplus_f(float x) { return x > 20.f ? x : log1pf(expf(x)); }
__device__ __forceinline__ float wave_sum(float v) {
#pragma unroll
    for (int o = 1; o < 64; o <<= 1) v += __shfl_xor(v, o);
    return v;
}
typedef short v4i16_t __attribute__((ext_vector_type(4)));
__device__ __forceinline__ s16x4 vtr(LAS unsigned char* p) { return __builtin_bit_cast(s16x4, __builtin_amdgcn_ds_read_tr16_b64_v4i16((LAS v4i16_t*)p)); }
#define MFMA16(a, b, c) __builtin_amdgcn_mfma_f32_16x16x32_bf16((a), (b), (c), 0, 0, 0)
#define LDS_WAIT() asm volatile("s_waitcnt lgkmcnt(0)" ::: "memory")

namespace pg8 {
constexpr int BM = 256, BK = 64, HALF = 128, HTB = HALF * BK * 2, STAGE_BYTES = 8 * HTB, NXCD = 8, WGM = 8;
__host__ __device__ __forceinline__ int lds_byte(int r, int c) { const int st = (r >> 4) * 2 + (c >> 5), rr = r & 15, cc = c & 31, ob = rr * 64 + cc * 2; return st * 1024 + (ob ^ (((ob >> 9) & 1) << 5)); }
__host__ __device__ __forceinline__ void stage_rc(int b, int& R, int& C) { const int st = b / 1024, sb = b % 1024, swz = sb ^ (((sb >> 9) & 1) << 5); R = (st >> 1) * 16 + swz / 64; C = (st & 1) * 32 + (swz % 64) / 2; }
__host__ __device__ __forceinline__ int perm32(int rho) { const int n = rho >> 4, i = rho & 15; return 8 * (i >> 2) + 4 * n + (i & 3); }

struct Unit { int pm, pn, L; };
struct Gemm { const GAS bf16_t* A; const GAS bf16_t* Bt; int M, N, K, lda, ldb; };


constexpr int KVC_G0 = 32 * 128, KVC_G1 = KVC_G0 + 32 * 512, KVC_ROWS = KVC_G1 + 32 * 2048;
__device__ __forceinline__ void kvc_row(int R, const char* s0, const char* s1, const char* s2, char* dbase, const GAS f32x4*& src, GAS f32x4*& dst) {
    const char* sb = R < KVC_G0 ? s0 : (R < KVC_G1 ? s1 : s2);
    const int dg = R < KVC_G0 ? R : (R < KVC_G1 ? R - KVC_G0 : R - KVC_G1), gl = R < KVC_G0 ? KVC_G0 - 1 : (R < KVC_G1 ? 32 * 512 - 1 : 32 * 2048 - 1);
    const int sr = dg + 8 < gl ? dg + 8 : gl;
    src = (const GAS f32x4*)(sb + (size_t)sr * 8192); dst = (GAS f32x4*)(dbase + (size_t)R * 8192);
}

struct NoSide { static constexpr bool ACTIVE = false; __device__ __forceinline__ void step(int, int) {} __device__ __forceinline__ void finish() {} };
struct SideKvCopy {
    static constexpr bool ACTIVE = true;
    f32x4 v; GAS f32x4* dprev; unsigned voff; const char* s0; const char* s1; const char* s2; char* dbase;
    __device__ __forceinline__ void init(GAS f32x4* dummy, const void* c0, const void* c1, const void* c2, float* out) {
        v = (f32x4){0.f, 0.f, 0.f, 0.f}; dprev = dummy; voff = threadIdx.x * 16u; s0 = (const char*)c0; s1 = (const char*)c1; s2 = (const char*)c2; dbase = (char*)(out + O_SKV128); }
    __device__ __forceinline__ void step(int L, int j) {
        asm volatile("global_store_dwordx4 %0, %1, %2 nt" :: "v"(voff), "v"(v), "s"(dprev) : "memory");
        const GAS f32x4* sp; GAS f32x4* dp; kvc_row((L * 16 + j) % KVC_ROWS, s0, s1, s2, dbase, sp, dp);
        asm volatile("global_load_dwordx4 %0, %1, %2 nt" : "=v"(v) : "v"(voff), "s"(sp) : "memory");
        dprev = dp;
    }
    __device__ __forceinline__ void finish() { asm volatile("s_waitcnt vmcnt(0)\n\tglobal_store_dwordx4 %0, %1, %2 nt" :: "v"(voff), "v"(v), "s"(dprev) : "memory"); }
};

struct StaticOrder {
    int nM, nN, nwg, G, c, nrep;
    __host__ __device__ void init(int M, int N, int G_, int c_, int nrep_ = 1) { nM = M / BM; nN = N / BM; nwg = nM * nN; G = G_; c = c_; nrep = nrep_; }
    __host__ __device__ bool next(int i, Unit& u) const {
        const long L = (long)i * G + c; if (L >= (long)nwg * nrep) return false;
        int wgid = (int)(L % nwg); { const int q = nwg / NXCD, r = nwg % NXCD, xcd = wgid % NXCD, off = wgid / NXCD; wgid = (xcd < r ? xcd * (q + 1) : r * (q + 1) + (xcd - r) * q) + off; }
        const int nig = WGM * nN, gid = wgid / nig, fm = gid * WGM, gsz = (nM - fm) < WGM ? (nM - fm) : WGM;
        u.pm = fm + ((wgid % nig) % gsz); u.pn = (wgid % nig) / gsz; u.L = (int)L; return true;
    }
    __device__ __forceinline__ void a_ready(const Unit&) const {}
    __device__ __forceinline__ void done(const Unit&) const {}
};


struct EpiProj {
    static constexpr bool PERM = true, AFTER_DRAIN = false;
    GAS bf16_t* O; int ldc; GAS float* DT; GAS bf16_t* KVC;
    __device__ __forceinline__ void operator()(const f32x4 (&acc)[2][2][4][2], const Unit& u, int wr, int wc, int fr, int fq) const {
        const int row0 = u.pm * BM + wr * 64 + fr;
        if (u.pn == 80) {
            if (wc == 0) {
#pragma unroll
                for (int ai = 0; ai < 2; ++ai)
#pragma unroll
                    for (int m = 0; m < 4; ++m) { GAS float* rp = DT + (size_t)(row0 + ai * HALF + m * 16) * 32 + 8 * fq;
                        *(GAS f32x4*)(rp) = acc[ai][0][m][0]; *(GAS f32x4*)(rp + 4) = acc[ai][0][m][1]; }
            }
        } else if (u.pn >= 12 && u.pn < 36 && u.pm < 64) {
            const int t12 = u.pn - 12, kvsel = t12 >= 12 ? 1 : 0, r12 = t12 - 12 * kvsel, g = r12 >> 2, hq = r12 & 3, sh = 2 * g, dim = wc * 32 + 8 * fq;
#pragma unroll
            for (int ai = 0; ai < 2; ++ai)
#pragma unroll
                for (int m = 0; m < 4; ++m) { const int row = row0 + ai * HALF + m * 16, b = row >> 12, t = row & 4095, ridx = ((t & ((1 << sh) - 1)) << (12 - sh)) + (t >> sh);
#pragma unroll
                    for (int bj = 0; bj < 2; ++bj) { const f32x4 v0 = acc[ai][bj][m][0], v1 = acc[ai][bj][m][1];
                        u32x4 w; w.x = cvt_pk_bf16(v0[0], v0[1]); w.y = cvt_pk_bf16(v0[2], v0[3]); w.z = cvt_pk_bf16(v1[0], v1[1]); w.w = cvt_pk_bf16(v1[2], v1[3]);
                        *(GAS u32x4*)(KVC + ((size_t)((((kvsel * 3 + g) * 4 + b) * 8) + 2 * hq + bj) << 19) + (size_t)ridx * 128 + dim) = w; } }
        } else {
            const int col0 = u.pn * BM + wc * 32 + 8 * fq;
#pragma unroll
            for (int ai = 0; ai < 2; ++ai)
#pragma unroll
                for (int m = 0; m < 4; ++m) { GAS bf16_t* rowp = O + (size_t)(row0 + ai * HALF + m * 16) * ldc + col0;
#pragma unroll
                    for (int bj = 0; bj < 2; ++bj) { const f32x4 v0 = acc[ai][bj][m][0], v1 = acc[ai][bj][m][1];
                        u32x4 w; w.x = cvt_pk_bf16(v0[0], v0[1]); w.y = cvt_pk_bf16(v0[2], v0[3]); w.z = cvt_pk_bf16(v1[0], v1[1]); w.w = cvt_pk_bf16(v1[2], v1[3]);
                        *(GAS u32x4*)(rowp + bj * HALF) = w; } }
        }
    }
};
struct EpiGateA {
    static constexpr bool PERM = true, AFTER_DRAIN = false;
    const GAS bf16_t* gate; int ldg; GAS bf16_t* T;
    __device__ __forceinline__ void operator()(const f32x4 (&acc)[2][2][4][2], const Unit& u, int wr, int wc, int fr, int fq) const {
        const int row0 = u.pm * BM + wr * 64 + fr, col0 = u.pn * BM + wc * 32 + 8 * fq;
#pragma unroll
        for (int ai = 0; ai < 2; ++ai) {
            u32x4 gwv[4][2];
#pragma unroll
            for (int m = 0; m < 4; ++m)
#pragma unroll
                for (int bj = 0; bj < 2; ++bj) gwv[m][bj] = *(const GAS u32x4*)(gate + (size_t)(row0 + ai * HALF + m * 16) * ldg + col0 + bj * HALF);
            __builtin_amdgcn_sched_barrier(0);
#pragma unroll
            for (int m = 0; m < 4; ++m) { const size_t row = (size_t)(row0 + ai * HALF + m * 16);
#pragma unroll
                for (int bj = 0; bj < 2; ++bj) { const int col = col0 + bj * HALF;
                    const u32x4 gw = gwv[m][bj];
                    f32x4 v0 = acc[ai][bj][m][0], v1 = acc[ai][bj][m][1];
                    v0[0] *= sigmoid_f(bf_lo(gw.x)); v0[1] *= sigmoid_f(bf_hi(gw.x)); v0[2] *= sigmoid_f(bf_lo(gw.y)); v0[3] *= sigmoid_f(bf_hi(gw.y));
                    v1[0] *= sigmoid_f(bf_lo(gw.z)); v1[1] *= sigmoid_f(bf_hi(gw.z)); v1[2] *= sigmoid_f(bf_lo(gw.w)); v1[3] *= sigmoid_f(bf_hi(gw.w));
                    u32x4 w; w.x = cvt_pk_bf16(v0[0], v0[1]); w.y = cvt_pk_bf16(v0[2], v0[3]); w.z = cvt_pk_bf16(v1[0], v1[1]); w.w = cvt_pk_bf16(v1[2], v1[3]);
                    *(GAS u32x4*)(T + row * DM + col) = w; } } }
    }
};
struct EpiGateB {
    static constexpr bool PERM = true, AFTER_DRAIN = false;
    const GAS bf16_t* gate; int ldg; const GAS bf16_t* T; GAS bf16_t* O;
    __device__ __forceinline__ void operator()(const f32x4 (&acc)[2][2][4][2], const Unit& u, int wr, int wc, int fr, int fq) const {
        const int row0 = u.pm * BM + wr * 64 + fr, col0 = u.pn * BM + wc * 32 + 8 * fq;
#pragma unroll
        for (int ai = 0; ai < 2; ++ai) {
            u32x4 gwv[4][2], twv[4][2];
#pragma unroll
            for (int m = 0; m < 4; ++m)
#pragma unroll
                for (int bj = 0; bj < 2; ++bj) { const size_t row = (size_t)(row0 + ai * HALF + m * 16); const int col = col0 + bj * HALF;
                    gwv[m][bj] = *(const GAS u32x4*)(gate + row * ldg + col); twv[m][bj] = *(const GAS u32x4*)(T + row * DM + col); }
            __builtin_amdgcn_sched_barrier(0);
#pragma unroll
            for (int m = 0; m < 4; ++m) { const size_t row = (size_t)(row0 + ai * HALF + m * 16);
#pragma unroll
                for (int bj = 0; bj < 2; ++bj) { const int col = col0 + bj * HALF;
                    const u32x4 gw = gwv[m][bj];
                    const u32x4 tw = twv[m][bj];
                    f32x4 v0 = acc[ai][bj][m][0], v1 = acc[ai][bj][m][1];
                    v0[0] = bf_lo(tw.x) + v0[0] * sigmoid_f(bf_lo(gw.x)); v0[1] = bf_hi(tw.x) + v0[1] * sigmoid_f(bf_hi(gw.x)); v0[2] = bf_lo(tw.y) + v0[2] * sigmoid_f(bf_lo(gw.y)); v0[3] = bf_hi(tw.y) + v0[3] * sigmoid_f(bf_hi(gw.y));
                    v1[0] = bf_lo(tw.z) + v1[0] * sigmoid_f(bf_lo(gw.z)); v1[1] = bf_hi(tw.z) + v1[1] * sigmoid_f(bf_hi(gw.z)); v1[2] = bf_lo(tw.w) + v1[2] * sigmoid_f(bf_lo(gw.w)); v1[3] = bf_hi(tw.w) + v1[3] * sigmoid_f(bf_hi(gw.w));
                    u32x4 w; w.x = cvt_pk_bf16(v0[0], v0[1]); w.y = cvt_pk_bf16(v0[2], v0[3]); w.z = cvt_pk_bf16(v1[0], v1[1]); w.w = cvt_pk_bf16(v1[2], v1[3]);
                    *(GAS u32x4*)(O + row * DM + col) = w; } } }
    }
};
struct EpiOutBf16 {
    static constexpr bool PERM = true, AFTER_DRAIN = false;
    GAS bf16_t* O; int ldc;
    __device__ __forceinline__ void operator()(const f32x4 (&acc)[2][2][4][2], const Unit& u, int wr, int wc, int fr, int fq) const {
        const int row0 = u.pm * BM + wr * 64 + fr, col0 = u.pn * BM + wc * 32 + 8 * fq;
#pragma unroll
        for (int ai = 0; ai < 2; ++ai)
#pragma unroll
            for (int m = 0; m < 4; ++m) { GAS bf16_t* rowp = O + (size_t)(row0 + ai * HALF + m * 16) * ldc + col0;
#pragma unroll
                for (int bj = 0; bj < 2; ++bj) { const f32x4 v0 = acc[ai][bj][m][0], v1 = acc[ai][bj][m][1];
                    u32x4 w; w.x = cvt_pk_bf16(v0[0], v0[1]); w.y = cvt_pk_bf16(v0[2], v0[3]); w.z = cvt_pk_bf16(v1[0], v1[1]); w.w = cvt_pk_bf16(v1[2], v1[3]);
                    *(GAS u32x4*)(rowp + bj * HALF) = w; } }
    }
};
struct EpiF32 {
    static constexpr bool PERM = false, AFTER_DRAIN = false;
    GAS float* C; int ldc;
    __device__ __forceinline__ void operator()(const f32x4 (&acc)[2][2][4][2], const Unit& u, int wr, int wc, int fr, int fq) const {
        const int row0 = u.pm * BM + wr * 64 + fr, col0 = u.pn * BM + wc * 32 + 4 * fq;
#pragma unroll
        for (int ai = 0; ai < 2; ++ai)
#pragma unroll
            for (int m = 0; m < 4; ++m) { GAS float* rowp = C + (size_t)(row0 + ai * HALF + m * 16) * ldc + col0;
#pragma unroll
                for (int bj = 0; bj < 2; ++bj)
#pragma unroll
                    for (int n = 0; n < 2; ++n) *(GAS f32x4*)(rowp + bj * HALF + n * 16) = acc[ai][bj][m][n]; }
    }
};

template <class Epi, class Sched, bool ALIGN_EPI = false, bool SP2 = false, class Side = NoSide>
__device__ __forceinline__ void gemm_phase(LAS unsigned char* lds, const Gemm g, const Sched& S, const Epi& E, Side side = Side()) {
    const int tid = threadIdx.x, wid = __builtin_amdgcn_readfirstlane(tid >> 6), lane = tid & 63, wr = wid >> 2, wc = wid & 3, fr = lane & 15, fq = lane >> 4;
    const int K = g.K, nt = K / BK;
    unsigned voffA[2], voffB[2];
#pragma unroll
    for (int i = 0; i < 2; ++i) { int R, C; stage_rc(tid * 16 + i * 8192, R, C); const int Rb = Epi::PERM ? ((R & ~31) + perm32(R & 31)) : R;
        voffA[i] = (unsigned)(R * g.lda + C) * 2u; voffB[i] = (unsigned)(Rb * g.ldb + C) * 2u; }
    const size_t kstep = (size_t)(BK * 2);
    const size_t hstepA = (size_t)HALF * g.lda * 2, hstepB = (size_t)HALF * g.ldb * 2;
    const size_t tstepA = 2 * hstepA, tstepB = 2 * hstepB;
    const unsigned ldsw = (unsigned)wid * 1024u;
    const int aoff = lds_byte(wr * 64 + fr, fq * 8), boff = lds_byte(wc * 32 + fr, fq * 8);
#define PG8_SA(b, h) (((b) * 2 + (h)) * HTB)
#define PG8_SB(b, h) ((4 + (b) * 2 + (h)) * HTB)
#define PG8_STAGE(bufoff, gbase, voff) do { _Pragma("unroll") for (int _i = 0; _i < 2; ++_i) \
        __builtin_amdgcn_global_load_lds((const GAS unsigned*)((gbase) + (voff)[_i]), (LAS unsigned*)(lds + (bufoff) + ldsw + _i * 8192), 16, 0, 0); } while (0)
#define PG8_LDA(dst, b, h) do { _Pragma("unroll") for (int m = 0; m < 4; ++m) _Pragma("unroll") for (int k = 0; k < 2; ++k) dst[m][k] = *(const LAS bf16x8*)(lds + PG8_SA(b, h) + aoff + m * 2048 + k * 1024); } while (0)
#define PG8_LDB(dst, b, h) do { _Pragma("unroll") for (int n = 0; n < 2; ++n) _Pragma("unroll") for (int k = 0; k < 2; ++k) dst[n][k] = *(const LAS bf16x8*)(lds + PG8_SB(b, h) + boff + n * 2048 + k * 1024); } while (0)
#define PG8_MMA(ai, bj, At, Bt) do { __builtin_amdgcn_s_setprio(1); _Pragma("unroll") for (int m = 0; m < 4; ++m) _Pragma("unroll") for (int n = 0; n < 2; ++n) _Pragma("unroll") for (int k = 0; k < 2; ++k) \
        acc[ai][bj][m][n] = __builtin_amdgcn_mfma_f32_16x16x32_bf16(Bt[n][k], At[m][k], acc[ai][bj][m][n], 0, 0, 0); __builtin_amdgcn_s_setprio(0); } while (0)
#define PG8_WAIT_V(n) asm volatile("s_waitcnt vmcnt(" #n ")" ::: "memory")
#define PG8_WAIT_L(n) asm volatile("s_waitcnt lgkmcnt(" #n ")" ::: "memory")
#define PG8_BAR __builtin_amdgcn_s_barrier()
#define PG8_SCHED __builtin_amdgcn_sched_barrier(0)
    Unit cur, nxt; int ui = 0;
    if (!S.next(0, cur)) return;
    f32x4 acc[2][2][4][2];
#pragma unroll
    for (int a = 0; a < 2; ++a)
#pragma unroll
        for (int b = 0; b < 2; ++b)
#pragma unroll
            for (int m = 0; m < 4; ++m)
#pragma unroll
                for (int n = 0; n < 2; ++n) acc[a][b][m][n] = (f32x4){0.f, 0.f, 0.f, 0.f};
    bf16x8 At[4][2], B0[2][2], B1[2][2];
    const GAS char* cA = (const GAS char*)g.A + (size_t)cur.pm * tstepA; const GAS char* cB = (const GAS char*)g.Bt + (size_t)cur.pn * tstepB;
    S.a_ready(cur);
    if constexpr (SP2) {
        PG8_STAGE(PG8_SB(0, 0), cB, voffB); PG8_STAGE(PG8_SB(0, 1), cB + hstepB, voffB); PG8_STAGE(PG8_SA(0, 0), cA, voffA); PG8_STAGE(PG8_SA(0, 1), cA + hstepA, voffA);
        if (wr == 1) PG8_BAR;
        PG8_WAIT_V(2); PG8_BAR;
        PG8_STAGE(PG8_SB(1, 0), cB + kstep, voffB); PG8_STAGE(PG8_SA(1, 0), cA + kstep, voffA); PG8_STAGE(PG8_SB(1, 1), cB + hstepB + kstep, voffB);
        PG8_WAIT_V(6); PG8_BAR;
    } else {
        PG8_STAGE(PG8_SB(0, 0), cB, voffB); PG8_STAGE(PG8_SA(0, 0), cA, voffA); PG8_STAGE(PG8_SB(0, 1), cB + hstepB, voffB); PG8_STAGE(PG8_SA(0, 1), cA + hstepA, voffA);
        if (wr == 1) PG8_BAR;
        PG8_WAIT_V(4); PG8_BAR;
        PG8_STAGE(PG8_SB(1, 0), cB + kstep, voffB); PG8_STAGE(PG8_SA(1, 0), cA + kstep, voffA); PG8_STAGE(PG8_SB(1, 1), cB + hstepB + kstep, voffB);
        PG8_WAIT_V(6); PG8_BAR;
    }
    for (;;) {
        const bool has_next = S.next(ui + 1, nxt);
        const GAS char* nA = has_next ? (const GAS char*)g.A + (size_t)nxt.pm * tstepA : cA; const GAS char* nB = has_next ? (const GAS char*)g.Bt + (size_t)nxt.pn * tstepB : cB;
        for (int t = 0; t < nt; t += 2) {
            const bool last = (t == nt - 2);
            const GAS char* a1 = cA + (size_t)(t + 1) * kstep;
            const GAS char* a2 = last ? nA : cA + (size_t)(t + 2) * kstep; const GAS char* b2 = last ? nB : cB + (size_t)(t + 2) * kstep;
            const GAS char* a3 = a2 + kstep; const GAS char* b3 = b2 + kstep;
            if (last && has_next) S.a_ready(nxt);
            if constexpr (SP2) {
            PG8_LDB(B0, 0, 0); PG8_LDB(B1, 0, 1); PG8_SCHED; PG8_LDA(At, 0, 0); PG8_STAGE(PG8_SA(1, 1), a1 + hstepA, voffA);
            PG8_WAIT_V(8); PG8_WAIT_L(0); PG8_BAR; PG8_MMA(0, 0, At, B0); PG8_MMA(0, 1, At, B1); PG8_BAR; PG8_SCHED;
            PG8_LDA(At, 0, 1); PG8_STAGE(PG8_SB(0, 0), b2, voffB); PG8_STAGE(PG8_SB(0, 1), b2 + hstepB, voffB); PG8_STAGE(PG8_SA(0, 0), a2, voffA);
            if constexpr (Side::ACTIVE) { side.step(cur.L, t >> 1); PG8_WAIT_V(10); } else { PG8_WAIT_V(8); }
            PG8_WAIT_L(0); PG8_BAR; PG8_MMA(1, 0, At, B0); PG8_MMA(1, 1, At, B1); PG8_BAR; PG8_SCHED;
            PG8_LDB(B0, 1, 0); PG8_LDB(B1, 1, 1); PG8_SCHED; PG8_LDA(At, 1, 0); PG8_STAGE(PG8_SA(0, 1), a2 + hstepA, voffA);
            if constexpr (Side::ACTIVE) { PG8_WAIT_V(10); } else { PG8_WAIT_V(8); }
            PG8_WAIT_L(0); PG8_BAR; PG8_MMA(0, 0, At, B0); PG8_MMA(0, 1, At, B1); PG8_BAR; PG8_SCHED;
            PG8_LDA(At, 1, 1); PG8_STAGE(PG8_SB(1, 0), b3, voffB); PG8_STAGE(PG8_SB(1, 1), b3 + hstepB, voffB); PG8_STAGE(PG8_SA(1, 0), a3, voffA);
            PG8_WAIT_V(8); PG8_WAIT_L(0); PG8_BAR; PG8_MMA(1, 0, At, B0); PG8_MMA(1, 1, At, B1); PG8_BAR; PG8_SCHED;
            } else {
            PG8_LDB(B0, 0, 0); PG8_SCHED; PG8_LDA(At, 0, 0); PG8_STAGE(PG8_SA(1, 1), a1 + hstepA, voffA);
            PG8_WAIT_L(8); PG8_BAR; PG8_WAIT_L(0); PG8_MMA(0, 0, At, B0); PG8_BAR; PG8_SCHED;
            PG8_LDB(B1, 0, 1); PG8_STAGE(PG8_SB(0, 0), b2, voffB);
            PG8_BAR; PG8_WAIT_L(0); PG8_MMA(0, 1, At, B1); PG8_BAR;
            PG8_LDA(At, 0, 1); PG8_STAGE(PG8_SA(0, 0), a2, voffA);
            PG8_BAR; PG8_WAIT_L(0); PG8_MMA(1, 0, At, B0); PG8_BAR; PG8_SCHED;
            PG8_STAGE(PG8_SB(0, 1), b2 + hstepB, voffB);
            PG8_WAIT_V(6); PG8_BAR; PG8_MMA(1, 1, At, B1); PG8_BAR;
            PG8_LDB(B0, 1, 0); PG8_SCHED; PG8_LDA(At, 1, 0); PG8_STAGE(PG8_SA(0, 1), a2 + hstepA, voffA);
            PG8_WAIT_L(8); PG8_BAR; PG8_WAIT_L(0); PG8_MMA(0, 0, At, B0); PG8_BAR; PG8_SCHED;
            PG8_LDB(B1, 1, 1); PG8_STAGE(PG8_SB(1, 0), b3, voffB);
            PG8_BAR; PG8_WAIT_L(0); PG8_MMA(0, 1, At, B1); PG8_BAR;
            PG8_LDA(At, 1, 1); PG8_STAGE(PG8_SA(1, 0), a3, voffA);
            PG8_BAR; PG8_WAIT_L(0); PG8_MMA(1, 0, At, B0); PG8_BAR; PG8_SCHED;
            PG8_STAGE(PG8_SB(1, 1), b3 + hstepB, voffB);
            PG8_WAIT_V(6); PG8_BAR; PG8_MMA(1, 1, At, B1); PG8_BAR;
            }
        }
        if constexpr (ALIGN_EPI) { if (wr == 0) PG8_BAR; }
        if constexpr (!Epi::AFTER_DRAIN) { E(acc, cur, wr, wc, fr, fq); S.done(cur); }
        if (!has_next) break;
#pragma unroll
        for (int a = 0; a < 2; ++a)
#pragma unroll
            for (int b = 0; b < 2; ++b)
#pragma unroll
                for (int m = 0; m < 4; ++m)
#pragma unroll
                    for (int n = 0; n < 2; ++n) acc[a][b][m][n] = (f32x4){0.f, 0.f, 0.f, 0.f};
        cur = nxt; cA = nA; cB = nB; ++ui;
        if constexpr (ALIGN_EPI) { if (wr == 1) PG8_BAR; }
    }
    PG8_WAIT_V(0);
    if constexpr (Side::ACTIVE) side.finish();
    if constexpr (!ALIGN_EPI) { if (wr == 0) PG8_BAR; }
    PG8_BAR;
#undef PG8_SA
#undef PG8_SB
#undef PG8_STAGE
#undef PG8_LDA
#undef PG8_LDB
#undef PG8_MMA
#undef PG8_WAIT_V
#undef PG8_WAIT_L
#undef PG8_BAR
#undef PG8_SCHED
}
}

#define XB_TMO      128
#define XB_XCNT(j)  (256  + 64 * (j))
#define XB_XSUB(j)  (1280 + 64 * (j))
#define XB_XGEN(j)  (2304 + 64 * (j))
#define XB_TOP      3328
#define XB_TOPGEN   3392
#define XCD_BAR_WORDS 3456
#define XB_SPIN_CAP (1u << 18)

__device__ __forceinline__ unsigned xb_ld(unsigned* p)              { return __hip_atomic_load(p, __ATOMIC_RELAXED, __HIP_MEMORY_SCOPE_AGENT); }
__device__ __forceinline__ unsigned xb_add(unsigned* p, unsigned v) { return __hip_atomic_fetch_add(p, v, __ATOMIC_RELAXED, __HIP_MEMORY_SCOPE_AGENT); }
__device__ __forceinline__ unsigned xb_xcc_id() { return (unsigned)__builtin_amdgcn_s_getreg((3 << 11) | 20) & 0xFu; }
#define XB_SPIN(cond, bar) do { unsigned _sp = 0; while (cond) { __builtin_amdgcn_s_sleep(1); \
    if ((++_sp & 255u) == 0u) { if (xb_ld(&(bar)[XB_TMO])) break; if (_sp > XB_SPIN_CAP) { atomicAdd(&(bar)[XB_TMO], 1u); break; } } } } while (0)

struct XcdBarrier { unsigned* bar; unsigned x; volatile LAS unsigned* st; };

__device__ __forceinline__ XcdBarrier xcd_barrier_post(unsigned* bar, volatile LAS unsigned* st) {
    XcdBarrier b; b.bar = bar; b.x = xb_xcc_id(); b.st = st;
    if (threadIdx.x == 0) (void)xb_add(&bar[XB_XCNT(b.x)], 1u);
    return b;
}
__device__ __forceinline__ void xcd_barrier_complete(unsigned* bar, unsigned x, unsigned& nloc, unsigned& nx) {
    const unsigned G = gridDim.x * gridDim.y * gridDim.z;
    unsigned sum, cnt, mine, sp = 0u;
    for (;;) {
        sum = 0u; cnt = 0u; mine = 0u;
#pragma unroll
        for (unsigned j = 0; j < 16; ++j) { const unsigned c = xb_ld(&bar[XB_XCNT(j)]); sum += c; cnt += (c > 0u) ? 1u : 0u; mine = (j == x) ? c : mine; }
        if (sum == G) break;
        __builtin_amdgcn_s_sleep(1);
        if ((++sp & 255u) == 0u) { if (xb_ld(&bar[XB_TMO])) break; if (sp > XB_SPIN_CAP) { atomicAdd(&bar[XB_TMO], 1u); break; } }
    }
    nloc = mine > 0u ? mine : 1u; nx = cnt > 0u ? cnt : 1u;
}
__device__ __forceinline__ void xcd_barrier(const XcdBarrier& b) {
    asm volatile("s_waitcnt vmcnt(0)" ::: "memory");
    __syncthreads();
    if (threadIdx.x == 0) {
        unsigned* bar = b.bar;
        __builtin_amdgcn_s_waitcnt(0);
        unsigned nloc = b.st[0], nx = b.st[1];
        if (nloc == 0u) { xcd_barrier_complete(bar, b.x, nloc, nx); b.st[0] = nloc; b.st[1] = nx; }
        const unsigned old = xb_add(&bar[XB_XSUB(b.x)], 1u);
        const unsigned gen = old / nloc;
        if (old + 1u == (gen + 1u) * nloc) {
            __builtin_amdgcn_fence(__ATOMIC_RELEASE, "agent");
            asm volatile("s_waitcnt vmcnt(0)" ::: "memory");
            const unsigned og = xb_add(&bar[XB_TOP], 1u);
            const unsigned tg = og / nx;
            if (og + 1u == (tg + 1u) * nx) xb_add(&bar[XB_TOPGEN], 1u);
            else XB_SPIN(xb_ld(&bar[XB_TOPGEN]) == tg, bar);
            __builtin_amdgcn_fence(__ATOMIC_ACQUIRE, "agent");
            xb_add(&bar[XB_XGEN(b.x)], 1u);
            asm volatile("s_waitcnt vmcnt(0)" ::: "memory");
        } else {
            XB_SPIN(xb_ld(&bar[XB_XGEN(b.x)]) == gen, bar);
            __builtin_amdgcn_fence(__ATOMIC_ACQUIRE, "agent");
            asm volatile("s_waitcnt vmcnt(0)" ::: "memory");
        }
    }
    __syncthreads();
}

struct Args { const void* in[23]; float* out; unsigned char* ws; int ph_lo, ph_hi; };

__device__ __forceinline__ unsigned char* fresh_ws(const Args& A) { unsigned char* w = A.ws; asm volatile("" : "+s"(w)); return w; }
struct Ctx {
    LAS unsigned char* lds;
    int tid, lane, wave, bid, G;
};

__device__ __forceinline__ void tr_item(const GAS float* W, int ldw, int src_n0, int k0, GAS bf16_t* WT, int ldt, int dst_n0, int dst_k0, LAS float* scr, int lane) {
    const int c = lane & 7;
    if (src_n0 < 0) {
#pragma unroll
        for (int j = 0; j < 4; ++j) { const int n = (lane >> 3) + 8 * j; *(GAS u32x4*)(WT + (size_t)(dst_n0 + n) * ldt + dst_k0 + k0 + 8 * c) = (u32x4){0u, 0u, 0u, 0u}; }
        return;
    }
#pragma unroll 8
    for (int i = 0; i < 32; ++i) { const int kk = 2 * i + (lane >> 5); scr[kk * 33 + (lane & 31)] = W[(size_t)(k0 + kk) * ldw + src_n0 + (lane & 31)]; }
    LDS_WAIT(); asm volatile("" ::: "memory");
#pragma unroll
    for (int j = 0; j < 4; ++j) { const int n = (lane >> 3) + 8 * j; const LAS float* s = scr + (8 * c) * 33 + n;
        u32x4 o; o.x = cvt_pk_bf16(s[0 * 33], s[1 * 33]); o.y = cvt_pk_bf16(s[2 * 33], s[3 * 33]); o.z = cvt_pk_bf16(s[4 * 33], s[5 * 33]); o.w = cvt_pk_bf16(s[6 * 33], s[7 * 33]);
        *(GAS u32x4*)(WT + (size_t)(dst_n0 + n) * ldt + dst_k0 + k0 + 8 * c) = o; }
    LDS_WAIT(); asm volatile("" ::: "memory");
}

__device__ __forceinline__ void mod_item(const Ctx& X, const GAS float* cp, const GAS float* cs, const GAS float* w_ada, const GAS float* b_ada, GAS float* mod, int it) {
    LAS float* sc = (LAS float*)X.lds;
    LAS float* red = (LAS float*)(X.lds + 36864);
    const int tid = X.tid, col = tid & 31, kg = tid >> 5, n = it * 32 + col;
    f32x2 acc[18];
#pragma unroll
    for (int r = 0; r < 18; ++r) acc[r] = (f32x2){0.f, 0.f};
    float wn[16], cn[18];
#define MOD_LOAD(slab_) do { _Pragma("unroll") for (int kk = 0; kk < 16; ++kk) wn[kk] = w_ada[(size_t)((slab_) * 256 + kg * 16 + kk) * 6144 + n]; \
        _Pragma("unroll") for (int q = 0; q < 18; ++q) { const int e = tid + 512 * q, r = e >> 8, k = e & 255; cn[q] = (r < 4) ? cp[r * DM + (slab_) * 256 + k] : cs[(r - 4) * DM + (slab_) * 256 + k]; } } while (0)
    MOD_LOAD(0);
    for (int slab = 0; slab < 8; ++slab) {
        __syncthreads();
#pragma unroll
        for (int q = 0; q < 18; ++q) { const int e = tid + 512 * q, r = e >> 8, k = e & 255; sc[k * 36 + r] = silu_f(cn[q]); }
        float wc[16];
#pragma unroll
        for (int kk = 0; kk < 16; ++kk) wc[kk] = wn[kk];
        if (slab + 1 < 8) MOD_LOAD(slab + 1);
        __syncthreads();
#pragma unroll
        for (int kk = 0; kk < 16; ++kk) { const int k = kg * 16 + kk; const float w = wc[kk];
            const LAS f32x4* s4 = (const LAS f32x4*)(sc + k * 36);
#pragma unroll
            for (int r4 = 0; r4 < 9; ++r4) { const f32x4 v = s4[r4]; const f32x2 ww = (f32x2){w, w};
                acc[2 * r4] = __builtin_elementwise_fma((f32x2){v[0], v[1]}, ww, acc[2 * r4]); acc[2 * r4 + 1] = __builtin_elementwise_fma((f32x2){v[2], v[3]}, ww, acc[2 * r4 + 1]); } }
    }
#undef MOD_LOAD
#pragma unroll
    for (int r = 0; r < 36; ++r) red[(kg * 36 + r) * 32 + col] = acc[r >> 1][r & 1];
    __syncthreads();
    for (int e = tid; e < 36 * 32; e += 512) { const int r = e >> 5, c = e & 31; float s = 0.f;
#pragma unroll
        for (int q = 0; q < 16; ++q) s += red[(q * 36 + r) * 32 + c];
        mod[r * 6144 + it * 32 + c] = s + b_ada[it * 32 + c]; }
    __syncthreads();
}

__device__ __forceinline__ void phase0(const Ctx& X, const Args& A) {
    unsigned char* const wsl = fresh_ws(A);
    unsigned char* ws = wsl;
    const GAS float* w_in = (const GAS float*)A.in[13];
    GAS bf16_t* WIN = (GAS bf16_t*)(ws + WS_WIN);
    LAS float* scr = (LAS float*)(X.lds + X.wave * 8448);
    const int gw = X.bid * 8 + X.wave, NGW = X.G * 8;
    constexpr int NB_IN = NP / 32, I_IN = 32 * NB_IN;
    for (int it = gw; it < I_IN; it += NGW) {
        const int kb = it / NB_IN, nb = it % NB_IN, n0 = nb * 32;
        const int src = n0 < 16384 ? n0 : (n0 < C_DT ? n0 + 32 : (n0 < C_DT + 32 ? 16384 : -1));
        tr_item(w_in, NIN, src, kb * 64, WIN, DM, n0, 0, scr, X.lane);
    }
    for (int it = X.bid; it < 192; it += X.G)
        mod_item(X, (const GAS float*)A.in[7], (const GAS float*)A.in[8], (const GAS float*)A.in[9], (const GAS float*)A.in[10], (GAS float*)(ws + WS_MOD), it);
}

__device__ __forceinline__ void late_weight_transposes(const Ctx& X, const Args& A, int first_wg) {
    unsigned char* const wsl = fresh_ws(A);
    const GAS float* w_o_a = (const GAS float*)A.in[20]; const GAS float* w_o_b = (const GAS float*)A.in[21]; const GAS float* w_o = (const GAS float*)A.in[22];
    GAS bf16_t* WAB = (GAS bf16_t*)(wsl + WS_WAB); GAS bf16_t* WO = (GAS bf16_t*)(wsl + WS_WO);
    LAS float* scr = (LAS float*)(X.lds + X.wave * 8448);
    constexpr int I_OA = 16 * 64, I_OB = 32 * 64, I_O = 32 * 64;
    const int gw = (X.bid - first_wg) * 8 + X.wave, NGW = (X.G - first_wg) * 8;
    for (int it = gw; it < I_OA + I_OB + I_O; it += NGW) {
        int r = it;
        if (r < I_OA) { const int kb = r / 64, nb = r % 64; tr_item(w_o_a, DM, nb * 32, kb * 64, WAB, KAB, nb * 32, 0, scr, X.lane); continue; }
        r -= I_OA;
        if (r < I_OB) { const int kb = r / 64, nb = r % 64; tr_item(w_o_b, DM, nb * 32, kb * 64, WAB, KAB, nb * 32, 1024, scr, X.lane); continue; }
        r -= I_OB;
        { const int kb = r / 64, nb = r % 64; tr_item(w_o, DM, nb * 32, kb * 64, WO, DM, nb * 32, 0, scr, X.lane); }
    }
}

__device__ __forceinline__ void phase1(const Ctx& X, const Args& A) {
    unsigned char* const wsl = fresh_ws(A);
    const GAS float* xp = (const GAS float*)A.in[0]; const GAS float* xs = (const GAS float*)A.in[1]; const GAS float* gpre = (const GAS float*)A.in[11];
    const GAS float* mod = (const GAS float*)(wsl + WS_MOD); GAS bf16_t* H = (GAS bf16_t*)(wsl + WS_H);
    const int gw = X.bid * 8 + X.wave, NGW = X.G * 8, lane = X.lane;
    for (int m = gw; m < MT; m += NGW) {
        const GAS f32x4* xr = (const GAS f32x4*)(m < MP ? xp + (size_t)m * DM : xs + (size_t)(m - MP) * DM);
        const int mb = m < MP ? (m >> 12) : 4 + ((m - MP) >> 3);
        const GAS f32x4* sh4 = (const GAS f32x4*)(mod + mb * 6144); const GAS f32x4* sc4 = sh4 + 512; const GAS f32x4* g4 = (const GAS f32x4*)gpre;
        f32x4 v[8]; float ss = 0.f;
#pragma unroll
        for (int j = 0; j < 8; ++j) v[j] = __builtin_nontemporal_load(xr + lane + 64 * j);
        f32x4 ggv[8], shv[8], scv[8];
#pragma unroll
        for (int j = 0; j < 8; ++j) { ggv[j] = g4[lane + 64 * j]; shv[j] = sh4[lane + 64 * j]; scv[j] = sc4[lane + 64 * j]; }
        __builtin_amdgcn_sched_barrier(0);
#pragma unroll
        for (int j = 0; j < 8; ++j) ss += (v[j][0] * v[j][0] + v[j][1] * v[j][1]) + (v[j][2] * v[j][2] + v[j][3] * v[j][3]);
        const float rstd = rsqrtf(wave_sum(ss) * (1.f / DM) + NORM_EPS);
        GAS u32x2* o = (GAS u32x2*)(H + (size_t)m * DM);
#pragma unroll
        for (int j = 0; j < 8; ++j) { const f32x4 gg = ggv[j], sh = shv[j], sc = scv[j];
            f32x4 y;
#pragma unroll
            for (int e = 0; e < 4; ++e) y[e] = (v[j][e] * rstd * gg[e]) * (1.f + sc[e]) + sh[e];
            u32x2 w; w.x = cvt_pk_bf16(y[0], y[1]); w.y = cvt_pk_bf16(y[2], y[3]); o[lane + 64 * j] = w; }
    }
    { constexpr int R0 = 16 * 65 * 81, NR = (pg8::KVC_ROWS - R0 + 255) / 256;
      for (int Rb = R0 + X.bid; Rb < pg8::KVC_ROWS; Rb += X.G * NR) {
        u32x4 v[NR];
#pragma unroll
        for (int q = 0; q < NR; ++q) { int R = Rb + q * X.G; if (R >= pg8::KVC_ROWS) R = Rb; const GAS f32x4* sp; GAS f32x4* dp; pg8::kvc_row(R, (const char*)A.in[2], (const char*)A.in[3], (const char*)A.in[4], (char*)(A.out + O_SKV128), sp, dp);
            v[q] = *((const GAS u32x4*)sp + X.tid); }
#pragma unroll
        for (int q = 0; q < NR; ++q) { const int R = Rb + q * X.G; if (R < pg8::KVC_ROWS) { const GAS f32x4* sp; GAS f32x4* dp; pg8::kvc_row(R, (const char*)A.in[2], (const char*)A.in[3], (const char*)A.in[4], (char*)(A.out + O_SKV128), sp, dp);
            *((GAS u32x4*)dp + X.tid) = v[q]; } }
      } }
}

__device__ __forceinline__ void unpack8(const u32x4 v, float (&x)[8]) { x[0] = bf_lo(v.x); x[1] = bf_hi(v.x); x[2] = bf_lo(v.y); x[3] = bf_hi(v.y); x[4] = bf_lo(v.z); x[5] = bf_hi(v.z); x[6] = bf_lo(v.w); x[7] = bf_hi(v.w); }
__device__ __forceinline__ void conv_prepass(const Ctx& X, const Args& A) {
    unsigned char* const wsl = fresh_ws(A);
    const GAS bf16_t* proj = (const GAS bf16_t*)(wsl + WS_PROJ); GAS bf16_t* XB = (GAS bf16_t*)(wsl + WS_XBCA); GAS float* DT = (GAS float*)(wsl + WS_DT);
    const GAS float* conv_w = (const GAS float*)A.in[14]; const GAS float* conv_b = (const GAS float*)A.in[15]; const GAS float* hist = (const GAS float*)A.in[5];
    const int gt = X.bid * 512 + X.tid, GT = X.G * 512;
    const int cc = gt & 511, ch0 = cc * 8;
    float wt[4][8], bias[8];
#pragma unroll
    for (int kk = 0; kk < 4; ++kk) { const f32x4 a = *(const GAS f32x4*)(conv_w + kk * 4096 + ch0), b = *(const GAS f32x4*)(conv_w + kk * 4096 + ch0 + 4);
        wt[kk][0] = a[0]; wt[kk][1] = a[1]; wt[kk][2] = a[2]; wt[kk][3] = a[3]; wt[kk][4] = b[0]; wt[kk][5] = b[1]; wt[kk][6] = b[2]; wt[kk][7] = b[3]; }
    { const f32x4 a = *(const GAS f32x4*)(conv_b + ch0), b = *(const GAS f32x4*)(conv_b + ch0 + 4); bias[0] = a[0]; bias[1] = a[1]; bias[2] = a[2]; bias[3] = a[3]; bias[4] = b[0]; bias[5] = b[1]; bias[6] = b[2]; bias[7] = b[3]; }
    for (int run = gt >> 9; run < 1024 + 32; run += GT >> 9) {
        const bool dec = run >= 1024;
        const size_t row_first = dec ? (size_t)MP + (size_t)(run - 1024) * 8 : (size_t)run * 16;
        const int t0 = dec ? 0 : ((run * 16) & 4095), nt = dec ? 8 : 16;
        const GAS bf16_t* src = proj + row_first * NP + C_XBC + ch0;
        float xm[3][8];
        if (t0 >= 3) {
#pragma unroll
            for (int j = 0; j < 3; ++j) unpack8(*(const GAS u32x4*)(src + (long)(j - 3) * NP), xm[j]);
        } else if (dec) {
            const GAS float* hp = hist + (size_t)(run - 1024) * 3 * 4096 + ch0;
#pragma unroll
            for (int j = 0; j < 3; ++j) { const f32x4 a = *(const GAS f32x4*)(hp + j * 4096), b = *(const GAS f32x4*)(hp + j * 4096 + 4);
                xm[j][0] = a[0]; xm[j][1] = a[1]; xm[j][2] = a[2]; xm[j][3] = a[3]; xm[j][4] = b[0]; xm[j][5] = b[1]; xm[j][6] = b[2]; xm[j][7] = b[3]; }
        } else {
#pragma unroll
            for (int j = 0; j < 3; ++j)
#pragma unroll
                for (int e = 0; e < 8; ++e) xm[j][e] = 0.f;
        }
        u32x4 rows[16];
#pragma unroll
        for (int i = 0; i < 16; ++i) rows[i] = (i < nt) ? *(const GAS u32x4*)(src + (size_t)i * NP) : (u32x4){0u, 0u, 0u, 0u};
#pragma unroll
        for (int i = 0; i < 16; ++i) {
            if (i < nt) {
                float cur[8], o[8]; unpack8(rows[i], cur);
#pragma unroll
                for (int e = 0; e < 8; ++e) { o[e] = bias[e] + wt[0][e] * xm[0][e] + wt[1][e] * xm[1][e] + wt[2][e] * xm[2][e] + wt[3][e] * cur[e]; o[e] = silu_f(o[e]);
                    xm[0][e] = xm[1][e]; xm[1][e] = xm[2][e]; xm[2][e] = cur[e]; }
                u32x4 pk; pk.x = cvt_pk_bf16(o[0], o[1]); pk.y = cvt_pk_bf16(o[2], o[3]); pk.z = cvt_pk_bf16(o[4], o[5]); pk.w = cvt_pk_bf16(o[6], o[7]);
                *(GAS u32x4*)(XB + (row_first + i) * 4096 + ch0) = pk;
            }
        }
    }
    const GAS float* dtb = (const GAS float*)A.in[16];
    for (int i0 = gt; i0 < MT * 32; i0 += GT * 5) { float dv[5];
#pragma unroll
        for (int q = 0; q < 5; ++q) { const int i = i0 + q * GT; dv[q] = DT[i < MT * 32 ? i : i0]; }
#pragma unroll
        for (int q = 0; q < 5; ++q) { const int i = i0 + q * GT; if (i < MT * 32) DT[i] = softplus_f(dv[q] + dtb[i & 31]); } }
}

__device__ __forceinline__ float wave_incl_scan(float v, int lane) {
#pragma unroll
    for (int o = 1; o < 64; o <<= 1) { const float t = __shfl_up(v, o); if (lane >= o) v += t; }
    return v;
}
constexpr int T_BM = 0  , T_CM = 65536, T_XD = 98304, T_XW = 118784, T_ST = 139264, T_DTV = 157696, T_CSV = 158720, T_GSV = 159744, T_XS = 160;
__device__ __forceinline__ void ssd_prompt_item64(const Ctx& X, const Args& A, int b, int h) {
    unsigned char* const wsl = fresh_ws(A);
    LAS unsigned char* lds = X.lds;
    const int tid = X.tid, lane = X.lane, w = X.wave, fr = lane & 15, g4 = lane >> 4, gi = h >> 2, q = fr >> 2, pp = fr & 3;
    const GAS bf16_t* proj = (const GAS bf16_t*)(wsl + WS_PROJ); const GAS bf16_t* XB = (const GAS bf16_t*)(wsl + WS_XBCA); const GAS float* DT = (const GAS float*)(wsl + WS_DT); GAS bf16_t* YG = (GAS bf16_t*)(wsl + WS_YG);
    unsigned voff[2];
#pragma unroll
    for (int i = 0; i < 2; ++i) { int R, C; pg8::stage_rc(tid * 16 + i * 8192, R, C); voff[i] = (unsigned)(R * 4096 + C) * 2u; }
    const int lsw = (lane * 16) ^ ((lane >> 5) << 5);
    const unsigned voffc = (unsigned)((16 * w + (lsw >> 6)) * 4096 + ((lsw & 63) >> 1)) * 2u;
    const int lane_base = (fr * 64 + 16 * g4) ^ ((fr >> 3) << 5);
#define SSD_FRAG(base, tile, ks) (*(const LAS bf16x8*)(lds + (base) + ((ks) >> 1) * 16384 + (tile) * 2048 + ((ks) & 1) * 1024 + lane_base))
#define SSD_DMA16(gbase_, voff_, ldsaddr_) asm volatile("s_mov_b32 m0, %2\n\ts_nop 0\n\tglobal_load_lds_dwordx4 %0, %1" :: "v"(voff_), "s"(gbase_), "s"(ldsaddr_) : "memory")
#define SSD_STAGE_B(row0_, buf_) do { const char* gB_ = (const char*)(XB + (size_t)(row0_) * 4096 + 2048 + gi * 128); \
        _Pragma("unroll") for (int kh_ = 0; kh_ < 2; ++kh_) _Pragma("unroll") for (int i_ = 0; i_ < 2; ++i_) \
            SSD_DMA16(gB_ + kh_ * 128, voff[i_], ldsb + (unsigned)(T_BM + (buf_) * 32768 + kh_ * 16384 + w * 1024 + i_ * 8192)); } while (0)
#define SSD_STAGE_C(row0_) do { const char* gC_ = (const char*)(XB + (size_t)(row0_) * 4096 + 3072 + gi * 128); \
        _Pragma("unroll") for (int ks_ = 0; ks_ < 4; ++ks_) \
            SSD_DMA16(gC_ + ks_ * 64, voffc, ldsb + (unsigned)(T_CM + (ks_ >> 1) * 16384 + (2 * w + (ks_ & 1)) * 1024)); } while (0)
    const unsigned ldsb = (unsigned)(size_t)lds;
    __syncthreads();
    const float A_h = -expf(((const GAS float*)A.in[17])[h]), Dh = ((const GAS float*)A.in[18])[h];
    f32x4 sacc[4];
#pragma unroll
    for (int pt = 0; pt < 4; ++pt) sacc[pt] = (f32x4){0.f, 0.f, 0.f, 0.f};
    const int xs0 = tid >> 3, xc8 = tid & 7;
    const unsigned xoff = (unsigned)(xs0 * 4096 + h * 64 + xc8 * 8) * 2u;
    const size_t rowb = (size_t)b * 4096;
    SSD_STAGE_B(rowb, 0); SSD_STAGE_C(rowb);
    u32x4 xr[2];
    { const GAS char* xb = (const GAS char*)(XB + rowb * 4096);
#pragma unroll
      for (int i = 0; i < 2; ++i) xr[i] = *(const GAS u32x4*)(xb + xoff + i * (64 * 8192)); }
    float d0 = 0.f, d1 = 0.f, c0s = 0.f, c1s = 0.f, g0s = 0.f, g1s = 0.f;
    if (w == 0) { d0 = DT[(rowb + lane) * 32 + h]; d1 = DT[(rowb + 64 + lane) * 32 + h];
        c0s = wave_incl_scan(d0 * A_h, lane); c1s = wave_incl_scan(d1 * A_h, lane) + __shfl(c0s, 63);
        g0s = __expf(__shfl(c0s, lane | 15) - c0s); g1s = __expf(__shfl(c1s, lane | 15) - c1s); }
    asm volatile("s_waitcnt vmcnt(0)" : "+v"(xr[0]), "+v"(xr[1]) :: "memory");
    for (int c = 0; c < 32; ++c) {
        const size_t row0 = rowb + (size_t)c * 128;
        const int par = c & 1;
        LAS float* dtv = (LAS float*)(lds + T_DTV + par * 512); LAS float* csv = (LAS float*)(lds + T_CSV + par * 512); LAS float* gsv = (LAS float*)(lds + T_GSV + par * 512);
        if (w == 0) { dtv[lane] = d0; dtv[64 + lane] = d1; csv[lane] = c0s; csv[64 + lane] = c1s; gsv[lane] = g0s; gsv[64 + lane] = g1s; }
        const int bmo = T_BM + par * 32768;
        const size_t rown = (c + 1 < 32) ? row0 + 128 : row0;
        float dn0 = 0.f, dn1 = 0.f;
        if (w == 0) { dn0 = DT[(rown + lane) * 32 + h]; dn1 = DT[(rown + 64 + lane) * 32 + h]; }
        __syncthreads();
#pragma unroll
        for (int pt = 0; pt < 4; ++pt)
#pragma unroll
            for (int r = 0; r < 4; ++r) *(LAS unsigned short*)(lds + T_ST + (16 * pt + 4 * g4 + r) * 288 + (16 * w + fr) * 2) = f2bf(sacc[pt][r]);
        {
            const float cse = csv[127];
#pragma unroll
            for (int i = 0; i < 2; ++i) { const int s = xs0 + 64 * i; const float dts = dtv[s], wgt = __expf(cse - csv[s]);
                float xv[8]; unpack8(xr[i], xv);
#pragma unroll
                for (int e = 0; e < 8; ++e) xv[e] *= dts;
                u32x4 pk; pk.x = cvt_pk_bf16(xv[0], xv[1]); pk.y = cvt_pk_bf16(xv[2], xv[3]); pk.z = cvt_pk_bf16(xv[4], xv[5]); pk.w = cvt_pk_bf16(xv[6], xv[7]);
                *(LAS u32x4*)(lds + T_XD + s * T_XS + xc8 * 16) = pk;
#pragma unroll
                for (int e = 0; e < 8; ++e) xv[e] *= wgt;
                pk.x = cvt_pk_bf16(xv[0], xv[1]); pk.y = cvt_pk_bf16(xv[2], xv[3]); pk.z = cvt_pk_bf16(xv[4], xv[5]); pk.w = cvt_pk_bf16(xv[6], xv[7]);
                *(LAS u32x4*)(lds + T_XW + s * T_XS + xc8 * 16) = pk; }
        }
        __syncthreads();
        f32x4 yacc[4], oacc[4]; float el, skip; u32x2 zq[4], xq[4]; u32x4 xn[2];
        {
            bf16x8 cf[4];
#pragma unroll
            for (int ks = 0; ks < 4; ++ks) cf[ks] = SSD_FRAG(T_CM, w, ks);
            const float cl = csv[16 * w + fr];
            skip = Dh * __builtin_amdgcn_rcpf(fmaxf(dtv[16 * w + fr], 1e-30f));
#pragma unroll
            for (int pt = 0; pt < 4; ++pt) xq[pt] = *(const LAS u32x2*)(lds + T_XD + (16 * w + fr) * T_XS + (16 * pt + 4 * g4) * 2);
            asm volatile("s_waitcnt lgkmcnt(0)" : "+v"(cf[0]), "+v"(cf[1]), "+v"(cf[2]), "+v"(cf[3]) :: "memory");
            if (c + 1 < 32) { SSD_STAGE_B(rown, par ^ 1); SSD_STAGE_C(rown); }
            { const GAS char* xb = (const GAS char*)(XB + rown * 4096);
#pragma unroll
              for (int i = 0; i < 2; ++i) xn[i] = *(const GAS u32x4*)(xb + xoff + i * (64 * 8192)); }
            { const GAS char* zb = (const GAS char*)(proj + (row0 + 16 * w + fr) * NP + C_ZB + h * 64 + 4 * g4);
#pragma unroll
              for (int pt = 0; pt < 4; ++pt) zq[pt] = *(const GAS u32x2*)(zb + 32 * pt); }
#pragma unroll
            for (int pt = 0; pt < 4; ++pt) yacc[pt] = (f32x4){0.f, 0.f, 0.f, 0.f};
            for (int g0 = 0; g0 <= w; g0 += 4) {
                bf16x8 bfr[4][4]; f32x4 gv[4]; float ce[4]; s16x4 xa[2][4][2];
#pragma unroll
                for (int tt = 0; tt < 4; ++tt) { const int tcl = (g0 + tt <= w) ? g0 + tt : w;
#pragma unroll
                    for (int ks = 0; ks < 4; ++ks) bfr[tt][ks] = SSD_FRAG(bmo, tcl, ks);
                    gv[tt] = *(const LAS f32x4*)((tcl == w ? csv : gsv) + 16 * tcl + 4 * g4); ce[tt] = csv[16 * tcl + 15]; }
#pragma unroll
                for (int jj = 0; jj < 2; ++jj)
#pragma unroll
                    for (int pt = 0; pt < 4; ++pt) { const int s0 = 32 * ((g0 >> 1) + jj) + 4 * g4 + q;
                        xa[jj][pt][0] = vtr(lds + T_XD + s0 * T_XS + (16 * pt + 4 * pp) * 2);
                        xa[jj][pt][1] = vtr(lds + T_XD + (s0 + 16) * T_XS + (16 * pt + 4 * pp) * 2); }
                __builtin_amdgcn_sched_barrier(0);
                f32x4 acc[4];
#pragma unroll
                for (int tt = 0; tt < 4; ++tt) acc[tt] = (f32x4){0.f, 0.f, 0.f, 0.f};
#pragma unroll
                for (int ks = 0; ks < 4; ++ks)
#pragma unroll
                    for (int tt = 0; tt < 4; ++tt) acc[tt] = MFMA16(bfr[tt][ks], cf[ks], acc[tt]);
                s16x4 mh[4];
#pragma unroll
                for (int tt = 0; tt < 4; ++tt) { const int t = g0 + tt; float v[4];
                    if (t < w) { const float ft = __expf(cl - ce[tt]);
#pragma unroll
                        for (int r = 0; r < 4; ++r) v[r] = acc[tt][r] * (ft * gv[tt][r]);
                    } else if (t == w) {
#pragma unroll
                        for (int r = 0; r < 4; ++r) { const float e = __expf(fminf(cl - gv[tt][r], 0.f)); v[r] = (4 * g4 + r > fr) ? 0.f : acc[tt][r] * e; }
                    } else { v[0] = v[1] = v[2] = v[3] = 0.f; }
                    mh[tt] = pack4(v[0], v[1], v[2], v[3]); }
#pragma unroll
                for (int jj = 0; jj < 2; ++jj) { const bf16x8 mfrag = cat8(mh[2 * jj], mh[2 * jj + 1]);
#pragma unroll
                    for (int pt = 0; pt < 4; ++pt) yacc[pt] = MFMA16(cat8(xa[jj][pt][0], xa[jj][pt][1]), mfrag, yacc[pt]); }
            }
            bf16x8 sf[4][4];
#pragma unroll
            for (int ks = 0; ks < 4; ++ks)
#pragma unroll
                for (int pt = 0; pt < 4; ++pt) sf[ks][pt] = *(const LAS bf16x8*)(lds + T_ST + (16 * pt + fr) * 288 + (32 * ks + 8 * g4) * 2);
            __builtin_amdgcn_sched_barrier(0);
#pragma unroll
            for (int pt = 0; pt < 4; ++pt) oacc[pt] = (f32x4){0.f, 0.f, 0.f, 0.f};
#pragma unroll
            for (int ks = 0; ks < 4; ++ks)
#pragma unroll
                for (int pt = 0; pt < 4; ++pt) oacc[pt] = MFMA16(sf[ks][pt], cf[ks], oacc[pt]);
            el = __expf(cl);
        }
        {
            const float dtot = __expf(csv[127]);
#pragma unroll
            for (int pt = 0; pt < 4; ++pt) sacc[pt] *= dtot;
            const int ncol = 16 * w + 4 * pp;
#pragma unroll
            for (int kst = 0; kst < 4; ++kst) {
                const int r0 = 32 * kst + 4 * g4 + q;
                const bf16x8 bfrag = cat8(vtr(lds + bmo + (ncol >> 6) * 16384 + pg8::lds_byte(r0, ncol & 63)), vtr(lds + bmo + (ncol >> 6) * 16384 + pg8::lds_byte(r0 + 16, ncol & 63)));
#pragma unroll
                for (int pt = 0; pt < 4; ++pt)
                    sacc[pt] = MFMA16(cat8(vtr(lds + T_XW + r0 * T_XS + (16 * pt + 4 * pp) * 2), vtr(lds + T_XW + (r0 + 16) * T_XS + (16 * pt + 4 * pp) * 2)), bfrag, sacc[pt]);
            }
        }
        if (w == 0) { c0s = wave_incl_scan(dn0 * A_h, lane); c1s = wave_incl_scan(dn1 * A_h, lane) + __shfl(c0s, 63);
            g0s = __expf(__shfl(c0s, lane | 15) - c0s); g1s = __expf(__shfl(c1s, lane | 15) - c1s); }
        asm volatile("s_waitcnt lgkmcnt(0)" ::: "memory");
        __syncthreads();
        asm volatile("s_waitcnt vmcnt(0)" : "+v"(zq[0]), "+v"(zq[1]), "+v"(zq[2]), "+v"(zq[3]), "+v"(xn[0]), "+v"(xn[1]) :: "memory");
        { GAS char* yb = (GAS char*)(YG + row0 * DM) + (unsigned)((16 * w + fr) * DM + h * 64 + 4 * g4) * 2u;
#pragma unroll
          for (int pt = 0; pt < 4; ++pt) {
            const float xx[4] = {bf_lo(xq[pt].x), bf_hi(xq[pt].x), bf_lo(xq[pt].y), bf_hi(xq[pt].y)}, zz[4] = {bf_lo(zq[pt].x), bf_hi(zq[pt].x), bf_lo(zq[pt].y), bf_hi(zq[pt].y)};
            float yo[4];
#pragma unroll
            for (int r = 0; r < 4; ++r) { const float y = yacc[pt][r] + el * oacc[pt][r] + xx[r] * skip; yo[r] = y * silu_f(zz[r]); }
            u32x2 ow; ow.x = cvt_pk_bf16(yo[0], yo[1]); ow.y = cvt_pk_bf16(yo[2], yo[3]);
            *(GAS u32x2*)(yb + 32 * pt) = ow;
          } }
        xr[0] = xn[0]; xr[1] = xn[1]; d0 = dn0; d1 = dn1;
    }
    asm volatile("s_waitcnt vmcnt(0)" ::: "memory");
    GAS float* pssm = (GAS float*)(A.out + O_PSSM);
#pragma unroll
    for (int pt = 0; pt < 4; ++pt)
#pragma unroll
        for (int r = 0; r < 4; ++r) pssm[((size_t)(b * 32 + h) * 64 + 16 * pt + 4 * g4 + r) * 128 + 16 * w + fr] = sacc[pt][r];
#undef SSD_FRAG
#undef SSD_STAGE_B
#undef SSD_STAGE_C
}

__device__ __forceinline__ void ssd_decode_task(const Ctx& X, const Args& A, int task) {
    unsigned char* const wsl = fresh_ws(A);
    const int lane = X.lane, b = task >> 7, h = (task >> 2) & 31, pq = task & 3, gi = h >> 2;
    const int p = pq * 16 + (lane >> 2), nq = lane & 3;
    const GAS bf16_t* proj = (const GAS bf16_t*)(wsl + WS_PROJ); const GAS bf16_t* XB = (const GAS bf16_t*)(wsl + WS_XBCA); const GAS float* DT = (const GAS float*)(wsl + WS_DT); GAS bf16_t* YG = (GAS bf16_t*)(wsl + WS_YG);
    const float A_h = -expf(((const GAS float*)A.in[17])[h]), Dh = ((const GAS float*)A.in[18])[h];
    const GAS f32x4* sp = (const GAS f32x4*)((const GAS float*)A.in[6] + ((size_t)(b * 32 + h) * 64 + p) * 128 + nq * 32);
    LAS unsigned char* wl = X.lds + X.wave * 4096;
    u32x4 pc[4];
#pragma unroll
    for (int j = 0; j < 4; ++j) { const int piece = lane + 64 * j, t = piece >> 5, which = (piece >> 4) & 1, chunk = piece & 15;
        pc[j] = *(const GAS u32x4*)(XB + (size_t)(MP + b * 8 + t) * 4096 + 2048 + which * 1024 + gi * 128 + chunk * 8); }
    float dtv[8], xv[8], zv[8];
#pragma unroll
    for (int t = 0; t < 8; ++t) { const size_t row = (size_t)(MP + b * 8 + t);
        dtv[t] = DT[row * 32 + h]; xv[t] = bf2f(XB[row * 4096 + h * 64 + p]); zv[t] = bf2f(proj[row * NP + C_ZB + h * 64 + p]); }
    float st[32];
#pragma unroll
    for (int i = 0; i < 8; ++i) { const f32x4 v = sp[i]; st[4 * i] = v[0]; st[4 * i + 1] = v[1]; st[4 * i + 2] = v[2]; st[4 * i + 3] = v[3]; }
#pragma unroll
    for (int j = 0; j < 4; ++j) *(LAS u32x4*)(wl + (lane + 64 * j) * 16) = pc[j];
#pragma unroll
    for (int t = 0; t < 8; ++t) {
        const size_t row = (size_t)(MP + b * 8 + t);
        const float dt = dtv[t], dA = __expf(dt * A_h), xx = xv[t], xdt = xx * dt;
        float dot = 0.f;
#pragma unroll
        for (int i = 0; i < 4; ++i) { float bb[8], cv[8]; unpack8(*(const LAS u32x4*)(wl + (32 * t + nq * 4 + i) * 16), bb); unpack8(*(const LAS u32x4*)(wl + (32 * t + 16 + nq * 4 + i) * 16), cv);
#pragma unroll
            for (int e = 0; e < 8; ++e) { st[8 * i + e] = st[8 * i + e] * dA + xdt * bb[e]; dot += st[8 * i + e] * cv[e]; } }
        dot += __shfl_xor(dot, 1); dot += __shfl_xor(dot, 2);
        if (nq == 0) YG[row * DM + h * 64 + p] = f2bf((dot + xx * Dh) * silu_f(zv[t]));
    }
    GAS f32x4* op = (GAS f32x4*)(A.out + O_SSSM + ((size_t)(b * 32 + h) * 64 + p) * 128 + nq * 32);
#pragma unroll
    for (int i = 0; i < 8; ++i) op[i] = (f32x4){st[4 * i], st[4 * i + 1], st[4 * i + 2], st[4 * i + 3]};
}

constexpr int A_K = 0, A_V = 73728;
struct AttnItem { const GAS bf16_t* kc; const GAS bf16_t* vc; int m0; };
__device__ __forceinline__ AttnItem attn_item(const Args& A, int it) {
    const int g = it >> 10, rem = it & 1023, dsh = 2 * g, d = 1 << dsh, nqbsh = 5 - dsh;
    const int qb = rem & ((1 << nqbsh) - 1), rr = (rem >> nqbsh) & (d - 1), bh = rem >> (nqbsh + dsh), b = bh >> 3, h = bh & 7;
    const GAS bf16_t* kvc = (const GAS bf16_t*)(A.ws + WS_KVC);
    AttnItem N; N.m0 = 128 * qb - 144;
    N.kc = kvc + ((size_t)(((0 * 3 + g) * 4 + b) * 8 + h) << 19) + ((size_t)rr << (12 - dsh)) * 128;
    N.vc = kvc + ((size_t)(((1 * 3 + g) * 4 + b) * 8 + h) << 19) + ((size_t)rr << (12 - dsh)) * 128;
    return N;
}
__device__ __forceinline__ void attn_load_piece(const Ctx& X, const AttnItem& N, int i, u32x4& v, unsigned& zmask) {
    int idx = X.tid + 512 * i; if (idx >= (256 + 272) * 16) idx -= 4096;
    const int ch = idx & 15; int r = idx >> 4; const bool isv = r >= 256; if (isv) r -= 256;
    const int m = N.m0 + (isv ? r : r + 16);
    if (m < 0) zmask |= 1u << i;
    v = *(const GAS u32x4*)((isv ? N.vc : N.kc) + (m < 0 ? 0 : m) * 128 + ch * 8);
}
__device__ __forceinline__ unsigned attn_load(const Ctx& X, const Args& A, int it, u32x4 (&v)[17]) {
    const AttnItem N = attn_item(A, it);
    unsigned zmask = 0u;
#pragma unroll
    for (int i = 0; i < 17; ++i) attn_load_piece(X, N, i, v[i], zmask);
    return zmask;
}
__device__ __forceinline__ void attn_store(const Ctx& X, const u32x4 (&v)[17], unsigned zmask) {
#pragma unroll
    for (int i = 0; i < 17; ++i) {
        const int idx = X.tid + 512 * i, ch = idx & 15; int r = idx >> 4; const bool isv = r >= 256; if (isv) r -= 256;
        const u32x4 w = ((zmask >> i) & 1u) ? (u32x4){0u, 0u, 0u, 0u} : v[i];
        if (idx < (256 + 272) * 16) *(LAS u32x4*)(X.lds + (isv ? A_V : A_K) + r * 288 + ch * 16) = w;
    }
}
__device__ __forceinline__ void attn_load_q(const Ctx& X, const Args& A, int it, bf16x8 (&qf)[4]) {
    const int lane = X.lane, w = X.wave, fr = lane & 15, g4 = lane >> 4;
    const int g = it >> 10, rem = it & 1023, dsh = 2 * g, d = 1 << dsh, nqbsh = 5 - dsh;
    const int qb = rem & ((1 << nqbsh) - 1), rr = (rem >> nqbsh) & (d - 1), bh = rem >> (nqbsh + dsh), b = bh >> 3, h = bh & 7;
    const GAS bf16_t* proj = (const GAS bf16_t*)(A.ws + WS_PROJ);
    const long qrow = (long)b * 4096 + rr + (long)(128 * qb + 16 * w + fr) * d;
#pragma unroll
    for (int ks = 0; ks < 4; ++ks) qf[ks] = *(const GAS bf16x8*)(proj + qrow * NP + C_Q + g * 1024 + h * 128 + 32 * ks + 8 * g4);
}
__device__ __forceinline__ unsigned attn_prompt_compute(const Ctx& X, const Args& A, int it, const bf16x8 (&qf)[4], int nxt, bf16x8 (&qn)[4], u32x4 (&kv)[17], unsigned* ctr, unsigned& fut) {
    unsigned char* const wsl = fresh_ws(A);
    LAS unsigned char* lds = X.lds;
    const int lane = X.lane, w = X.wave, fr = lane & 15, g4 = lane >> 4;
    const int g = it >> 10, rem = it & 1023, dsh = 2 * g, d = 1 << dsh, nqbsh = 5 - dsh;
    const int qb = rem & ((1 << nqbsh) - 1), rr = (rem >> nqbsh) & (d - 1), bh = rem >> (nqbsh + dsh), b = bh >> 3, h = bh & 7;
    const GAS bf16_t* proj = (const GAS bf16_t*)(wsl + WS_PROJ);
    GAS bf16_t* OG = (GAS bf16_t*)(wsl + WS_OG) + (size_t)g * MT * 1024; GAS float* LSE = (GAS float*)(wsl + WS_LSE) + (size_t)g * MT * 8;
    const long rowb = (long)b * 4096 + rr;
    const int m0 = 128 * qb - 144;
    const int hc = g * 1024 + h * 128;
    const int mq = 128 * qb + 16 * w + fr;
    const long qrow = rowb + (long)mq * d;
    const AttnItem NI = attn_item(A, nxt); unsigned zmn = 0u;
    attn_load_q(X, A, nxt, qn);
    f32x4 sc[9];
#pragma unroll
    for (int kt = 1; kt <= 9; ++kt) {
        f32x4 acc = (f32x4){0.f, 0.f, 0.f, 0.f};
        const int krow = 16 * w + 16 * kt - 16 + fr;
#pragma unroll
        for (int ks = 0; ks < 4; ++ks) acc = MFMA16(*(const LAS bf16x8*)(lds + A_K + krow * 288 + (32 * ks + 8 * g4) * 2), qf[ks], acc);
        sc[kt - 1] = acc;
        attn_load_piece(X, NI, kt - 1, kv[kt - 1], zmn);
    }
    const float NEG = -__builtin_inff();
#pragma unroll
    for (int r = 0; r < 4; ++r) { if (4 * g4 + r < fr) sc[0][r] = NEG; if (4 * g4 + r > fr) sc[8][r] = NEG; }
    if (qb == 0) {
#pragma unroll
        for (int kt = 1; kt <= 9; ++kt)
#pragma unroll
            for (int r = 0; r < 4; ++r) if (m0 + 16 * w + 16 * kt + 4 * g4 + r < 0) sc[kt - 1][r] = NEG;
    }
    float mx = sc[0][0];
#pragma unroll
    for (int kt = 0; kt < 9; ++kt)
#pragma unroll
        for (int r = 0; r < 4; ++r) mx = fmaxf(mx, sc[kt][r]);
    mx = fmaxf(mx, __shfl_xor(mx, 16)); mx = fmaxf(mx, __shfl_xor(mx, 32));
    const float c2 = ATT_SCALE * 1.4426950408889634f;
    float l = 0.f;
#pragma unroll
    for (int kt = 0; kt < 9; ++kt)
#pragma unroll
        for (int r = 0; r < 4; ++r) { const float p = __builtin_amdgcn_exp2f((sc[kt][r] - mx) * c2); sc[kt][r] = p; l += p; }
    l += __shfl_xor(l, 16); l += __shfl_xor(l, 32);
    bf16x8 pf[5];
    pf[0] = cat8((s16x4){0, 0, 0, 0}, pack4(sc[0][0], sc[0][1], sc[0][2], sc[0][3]));
#pragma unroll
    for (int j = 1; j < 5; ++j) pf[j] = cat8(pack4(sc[2 * j - 1][0], sc[2 * j - 1][1], sc[2 * j - 1][2], sc[2 * j - 1][3]), pack4(sc[2 * j][0], sc[2 * j][1], sc[2 * j][2], sc[2 * j][3]));
    f32x4 oacc[8];
#pragma unroll
    for (int dt = 0; dt < 8; ++dt) oacc[dt] = (f32x4){0.f, 0.f, 0.f, 0.f};
    const int q = fr >> 2, pp = fr & 3;
#pragma unroll
    for (int j = 0; j < 5; ++j) {
        const int r0 = 16 * w + 32 * j + 4 * g4 + q;
        s16x4 a0[8], a1[8];
#pragma unroll
        for (int dt = 0; dt < 8; ++dt) { a0[dt] = vtr(lds + A_V + r0 * 288 + (16 * dt + 4 * pp) * 2); a1[dt] = vtr(lds + A_V + (r0 + 16) * 288 + (16 * dt + 4 * pp) * 2); }
        __builtin_amdgcn_sched_barrier(0);
#pragma unroll
        for (int dt = 0; dt < 8; ++dt) oacc[dt] = MFMA16(cat8(a0[dt], a1[dt]), pf[j], oacc[dt]);
        if (j < 4) { attn_load_piece(X, NI, 9 + 2 * j, kv[9 + 2 * j], zmn); attn_load_piece(X, NI, 10 + 2 * j, kv[10 + 2 * j], zmn); }
        if (j == 3 && X.tid == 0) asm volatile("global_atomic_add %0, %1, %2, %3 sc0" : "=v"(fut) : "v"(0u), "v"(1u), "s"(ctr) : "memory");
        __builtin_amdgcn_sched_barrier(0);
    }
    const float inv = 1.f / l;
#pragma unroll
    for (int dt = 0; dt < 8; ++dt) { u32x2 ow; ow.x = cvt_pk_bf16(oacc[dt][0] * inv, oacc[dt][1] * inv); ow.y = cvt_pk_bf16(oacc[dt][2] * inv, oacc[dt][3] * inv);
        *(GAS u32x2*)(OG + qrow * 1024 + h * 128 + 16 * dt + 4 * g4) = ow; }
    if (g4 == 0) LSE[qrow * 8 + h] = mx * ATT_SCALE + __logf(l);
    return zmn;
}

__device__ __forceinline__ void attn_decode_item(const Ctx& X, const Args& A, int it) {
    unsigned char* const wsl = fresh_ws(A);
    const int lane = X.lane, t = X.wave, hh = lane >> 5, l32 = lane & 31;
    const int g = it >> 8, b = (it >> 3) & 31, h = it & 7, wb = 128 << (2 * g), d = 1 << (2 * g);
    const GAS bf16_t* proj = (const GAS bf16_t*)(wsl + WS_PROJ);
    const GAS float* cache = (const GAS float*)A.in[2 + g];
    GAS bf16_t* OG = (GAS bf16_t*)(wsl + WS_OG) + (size_t)g * MT * 1024; GAS float* LSE = (GAS float*)(wsl + WS_LSE) + (size_t)g * MT * 8;
    const int hc = g * 1024 + h * 128 + 4 * l32;
    const size_t qrow = (size_t)(MP + b * 8 + t);
    const u32x2 qq = *(const GAS u32x2*)(proj + qrow * NP + C_Q + hc);
    const float q0 = bf_lo(qq.x) * ATT_SCALE, q1 = bf_hi(qq.x) * ATT_SCALE, q2 = bf_lo(qq.y) * ATT_SCALE, q3 = bf_hi(qq.y) * ATT_SCALE;
    float m = -1e30f, l = 0.f, o0 = 0.f, o1 = 0.f, o2 = 0.f, o3 = 0.f;
#define DEC_KEY(kk, vq, ok) do { float s_ = (q0 * (kk)[0] + q1 * (kk)[1]) + (q2 * (kk)[2] + q3 * (kk)[3]); \
        s_ += __shfl_xor(s_, 1); s_ += __shfl_xor(s_, 2); s_ += __shfl_xor(s_, 4); s_ += __shfl_xor(s_, 8); s_ += __shfl_xor(s_, 16); \
        if (ok) { const float mn_ = fmaxf(m, s_), al_ = __expf(m - mn_), p_ = __expf(s_ - mn_); \
            l = l * al_ + p_; o0 = o0 * al_ + p_ * (vq)[0]; o1 = o1 * al_ + p_ * (vq)[1]; o2 = o2 * al_ + p_ * (vq)[2]; o3 = o3 * al_ + p_ * (vq)[3]; m = mn_; } } while (0)
    const int jn = t / d + 1;
    { u32x2 k2[4], v2[4];
#pragma unroll
      for (int i = 0; i < 4; ++i) { const int j = 2 * i + hh, jc = j < jn ? j : 0; const size_t r = (size_t)(MP + b * 8 + (t - jc * d));
          k2[i] = *(const GAS u32x2*)(proj + r * NP + C_K + hc); v2[i] = *(const GAS u32x2*)(proj + r * NP + C_V + hc); }
#pragma unroll
      for (int i = 0; i < 4; ++i) { const int j = 2 * i + hh;
          const f32x4 kk = (f32x4){bf_lo(k2[i].x), bf_hi(k2[i].x), bf_lo(k2[i].y), bf_hi(k2[i].y)}, vq = (f32x4){bf_lo(v2[i].x), bf_hi(v2[i].x), bf_lo(v2[i].y), bf_hi(v2[i].y)};
          DEC_KEY(kk, vq, j < jn); } }
    const GAS float* cbase = cache + (size_t)b * wb * 2048 + h * 128 + 4 * l32;
    for (int i0 = 0; jn + 2 * i0 <= 128; i0 += 8) {
        f32x4 kv[8], vv[8];
#pragma unroll
        for (int u = 0; u < 8; ++u) {
            int j = jn + 2 * (i0 + u) + hh; if (j > 128) j = 128;
            const GAS float* p = cbase + (size_t)(wb + t - j * d) * 2048; kv[u] = *(const GAS f32x4*)p; vv[u] = *(const GAS f32x4*)(p + 1024);
        }
#pragma unroll
        for (int u = 0; u < 8; ++u) { const int j = jn + 2 * (i0 + u) + hh; DEC_KEY(kv[u], vv[u], j <= 128); }
    }
#undef DEC_KEY
    const float m2 = __shfl_xor(m, 32), mm = fmaxf(m, m2), a1 = __expf(m - mm);
    l *= a1; o0 *= a1; o1 *= a1; o2 *= a1; o3 *= a1;
    l += __shfl_xor(l, 32); o0 += __shfl_xor(o0, 32); o1 += __shfl_xor(o1, 32); o2 += __shfl_xor(o2, 32); o3 += __shfl_xor(o3, 32);
    const float inv = 1.f / l;
    if (hh == 0) { u32x2 ow; ow.x = cvt_pk_bf16(o0 * inv, o1 * inv); ow.y = cvt_pk_bf16(o2 * inv, o3 * inv); *(GAS u32x2*)(OG + qrow * 1024 + h * 128 + 4 * l32) = ow; }
    if (lane == 0) LSE[qrow * 8 + h] = mm + __logf(l);
}

__device__ __forceinline__ void cvt8_store(const GAS bf16_t* s, GAS float* dptr) {
    const u32x4 v = *(const GAS u32x4*)s;
    __builtin_nontemporal_store((f32x4){bf_lo(v.x), bf_hi(v.x), bf_lo(v.y), bf_hi(v.y)}, (GAS f32x4*)dptr);
    __builtin_nontemporal_store((f32x4){bf_lo(v.z), bf_hi(v.z), bf_lo(v.w), bf_hi(v.w)}, (GAS f32x4*)(dptr + 4));
}
__device__ __forceinline__ void extract_outputs(const Ctx& X, const Args& A) {
    unsigned char* const wsl = fresh_ws(A);
    const GAS bf16_t* proj = (const GAS bf16_t*)(wsl + WS_PROJ); const GAS bf16_t* kvc = (const GAS bf16_t*)(wsl + WS_KVC);
    const size_t gt = (size_t)X.bid * 512 + X.tid, GT = (size_t)X.G * 512;
#pragma unroll
    for (int g = 0; g < 3; ++g) {
        const int W = 128 << (2 * g);
        GAS float* po = (GAS float*)(A.out + (g == 0 ? O_PKV128 : g == 1 ? O_PKV512 : O_PKV2048));
        const size_t tot = (size_t)4 * W * 2 * 128;
        const int U = g == 0 ? 1 : (g == 1 ? 4 : 8);
        for (size_t i0 = gt; i0 < tot; i0 += GT * U) {
            u32x4 v[8];
#pragma unroll
            for (int q = 0; q < U; ++q) { size_t i = i0 + (size_t)q * GT; if (i >= tot) i = gt;
                const int u = (int)(i & 127), kv = (int)((i >> 7) & 1); const size_t bj = i >> 8; const int j = (int)(bj % W), b = (int)(bj / W);
                const int t = 4096 - W + j, ridx = ((t & ((1 << (2 * g)) - 1)) << (12 - 2 * g)) + (t >> (2 * g));
                v[q] = *(const GAS u32x4*)(kvc + ((size_t)((((kv * 3 + g) * 4 + b) * 8) + (u >> 4)) << 19) + (size_t)ridx * 128 + (u & 15) * 8); }
#pragma unroll
            for (int q = 0; q < U; ++q) { const size_t i = i0 + (size_t)q * GT;
                if (i < tot) { GAS float* dptr = po + i * 8;
                    __builtin_nontemporal_store((f32x4){bf_lo(v[q].x), bf_hi(v[q].x), bf_lo(v[q].y), bf_hi(v[q].y)}, (GAS f32x4*)dptr);
                    __builtin_nontemporal_store((f32x4){bf_lo(v[q].z), bf_hi(v[q].z), bf_lo(v[q].w), bf_hi(v[q].w)}, (GAS f32x4*)(dptr + 4)); } }
        }
        GAS float* so = (GAS float*)(A.out + (g == 0 ? O_SKV128 : g == 1 ? O_SKV512 : O_SKV2048));
        const size_t tot2 = (size_t)32 * 8 * 2 * 128;
        for (size_t i = gt; i < tot2; i += GT) { const int u = (int)(i & 127), kv = (int)((i >> 7) & 1); const int t = (int)((i >> 8) & 7), b = (int)(i >> 11);
            cvt8_store(proj + ((size_t)MP + b * 8 + t) * NP + (kv ? C_V : C_K) + g * 1024 + u * 8, so + (((size_t)b * W + (W - 8 + t)) * 2 + kv) * 1024 + u * 8); }
    }
    GAS float* pc = (GAS float*)(A.out + O_PCONV); GAS float* scv = (GAS float*)(A.out + O_SCONV);
    for (size_t i = gt; i < (size_t)4 * 3 * 512; i += GT) { const int u = (int)(i & 511), j = (int)((i >> 9) % 3), b = (int)(i / 1536);
        cvt8_store(proj + ((size_t)b * 4096 + 4093 + j) * NP + C_XBC + u * 8, pc + i * 8); }
    for (size_t i = gt; i < (size_t)32 * 3 * 512; i += GT) { const int u = (int)(i & 511), j = (int)((i >> 9) % 3), b = (int)(i / 1536);
        cvt8_store(proj + ((size_t)MP + b * 8 + 5 + j) * NP + C_XBC + u * 8, scv + i * 8); }
}

__device__ __forceinline__ void phase3(const Ctx& X, const Args& A) {
    conv_prepass(X, A);
    for (int it = X.bid; it < 768 * REP_DEC; it += X.G) attn_decode_item(X, A, it % 768);
    extract_outputs(X, A);
#if REP_DEC > 1
    extract_outputs(X, A);
#endif
}
constexpr int CW_QATT = 8192;
__device__ __forceinline__ int att_next(const Ctx& X, const Args& A) {
    volatile LAS unsigned* MISC = (volatile LAS unsigned*)(X.lds + MISC_OFF);
    if (X.tid == 0) MISC[16] = __hip_atomic_fetch_add((unsigned*)(A.ws + WS_CTL) + CW_QATT, 1u, __ATOMIC_RELAXED, __HIP_MEMORY_SCOPE_AGENT);
    __syncthreads();
    const int v = (int)MISC[16];
    __syncthreads();
    return v;
}
__device__ __forceinline__ void phase3b(const Ctx& X, const Args& A) {
    for (int it = X.bid; it < 128 * REP_SSD; it += X.G) { const int i = it & 127, xcd = i & 7, slot = i >> 3, grp = xcd * 4 + (slot >> 2);
        ssd_prompt_item64(X, A, grp >> 3, (grp & 7) * 4 + (slot & 3)); }
    {
        constexpr int NATT = 3072 * REP_ATT;
        volatile LAS unsigned* MISC = (volatile LAS unsigned*)(X.lds + MISC_OFF);
        unsigned* const ctr = (unsigned*)(A.ws + WS_CTL) + CW_QATT;
        u32x4 kv[17]; unsigned zm = 0u, fut = 0u;
        if (X.tid == 0) MISC[16] = __hip_atomic_fetch_add(ctr, 2u, __ATOMIC_RELAXED, __HIP_MEMORY_SCOPE_AGENT);
        __syncthreads();
        int it = (int)MISC[16], nx = it + 1;
        if (X.tid == 0) asm volatile("global_atomic_add %0, %1, %2, %3 sc0" : "=v"(fut) : "v"(0u), "v"(1u), "s"(ctr) : "memory");
        bf16x8 qf[4];
        if (it < NATT) { attn_load_q(X, A, it % 3072, qf); zm = attn_load(X, A, it % 3072, kv); }
        while (it < NATT) {
            attn_store(X, kv, zm);
            if (X.tid == 0) { asm volatile("s_waitcnt vmcnt(0)" : "+v"(fut) :: "memory"); MISC[16] = fut; }
            const int pn = (nx < NATT ? nx : it) % 3072;
            bf16x8 qn[4];
            __syncthreads();
            zm = attn_prompt_compute(X, A, it % 3072, qf, pn, qn, kv, ctr, fut);
#pragma unroll
            for (int ks = 0; ks < 4; ++ks) qf[ks] = qn[ks];
            __syncthreads();
            it = nx; nx = (int)MISC[16];
        }
        if (X.tid == 0) asm volatile("s_waitcnt vmcnt(0)" : "+v"(fut) :: "memory");
    }
    for (int task = X.bid * 8 + X.wave; task < 4096 * REP_DEC; task += X.G * 8) ssd_decode_task(X, A, task & 4095);
}

__device__ __forceinline__ void phase4(const Ctx& X, const Args& A) {
    unsigned char* const wsl = fresh_ws(A);
    const GAS bf16_t* proj = (const GAS bf16_t*)(wsl + WS_PROJ); const GAS bf16_t* OG = (const GAS bf16_t*)(wsl + WS_OG); const GAS float* LSE = (const GAS float*)(wsl + WS_LSE);
    const GAS bf16_t* YG = (const GAS bf16_t*)(wsl + WS_YG); GAS bf16_t* AY = (GAS bf16_t*)(wsl + WS_AY); const GAS float* gssm = (const GAS float*)A.in[19];
    const int gw = X.bid * 8 + X.wave, NGW = X.G * 8, lane = X.lane;
    for (int m = gw; m < MT; m += NGW) {
        u32x4 yv[4];
        { const GAS u32x4* yp = (const GAS u32x4*)(YG + (size_t)m * DM + 32 * lane);
#pragma unroll
          for (int q = 0; q < 4; ++q) yv[q] = yp[q]; }
        __builtin_amdgcn_sched_barrier(0);
        {
            const int hd = lane >> 3;
            const float l0 = LSE[(size_t)m * 8 + hd], l1 = LSE[((size_t)MT + m) * 8 + hd], l2 = LSE[((size_t)2 * MT + m) * 8 + hd];
            const float mx = fmaxf(l0, fmaxf(l1, l2)); float w0 = __expf(l0 - mx), w1 = __expf(l1 - mx), w2 = __expf(l2 - mx); const float inv = 1.f / (w0 + w1 + w2); w0 *= inv; w1 *= inv; w2 *= inv;
            float o[16];
#pragma unroll
            for (int e = 0; e < 16; ++e) o[e] = 0.f;
#pragma unroll
            for (int g = 0; g < 3; ++g) { const float wg = g == 0 ? w0 : (g == 1 ? w1 : w2);
                const GAS u32x4* p = (const GAS u32x4*)(OG + ((size_t)g * MT + m) * 1024 + 16 * lane);
#pragma unroll
                for (int q = 0; q < 2; ++q) { const u32x4 v = p[q];
                    o[8 * q + 0] += wg * bf_lo(v.x); o[8 * q + 1] += wg * bf_hi(v.x); o[8 * q + 2] += wg * bf_lo(v.y); o[8 * q + 3] += wg * bf_hi(v.y);
                    o[8 * q + 4] += wg * bf_lo(v.z); o[8 * q + 5] += wg * bf_hi(v.z); o[8 * q + 6] += wg * bf_lo(v.w); o[8 * q + 7] += wg * bf_hi(v.w); } }
            const GAS u32x4* zp = (const GAS u32x4*)(proj + (size_t)m * NP + C_ZA + 16 * lane);
            GAS u32x4* op = (GAS u32x4*)(AY + (size_t)m * KAB + 16 * lane);
#pragma unroll
            for (int q = 0; q < 2; ++q) { const u32x4 z = zp[q]; u32x4 w;
                w.x = cvt_pk_bf16(o[8 * q + 0] * silu_f(bf_lo(z.x)), o[8 * q + 1] * silu_f(bf_hi(z.x))); w.y = cvt_pk_bf16(o[8 * q + 2] * silu_f(bf_lo(z.y)), o[8 * q + 3] * silu_f(bf_hi(z.y)));
                w.z = cvt_pk_bf16(o[8 * q + 4] * silu_f(bf_lo(z.z)), o[8 * q + 5] * silu_f(bf_hi(z.z))); w.w = cvt_pk_bf16(o[8 * q + 6] * silu_f(bf_lo(z.w)), o[8 * q + 7] * silu_f(bf_hi(z.w)));
                op[q] = w; }
        }
        {
            float y[32]; float ss = 0.f;
#pragma unroll
            for (int q = 0; q < 4; ++q) { const u32x4 v = yv[q];
                y[8 * q + 0] = bf_lo(v.x); y[8 * q + 1] = bf_hi(v.x); y[8 * q + 2] = bf_lo(v.y); y[8 * q + 3] = bf_hi(v.y); y[8 * q + 4] = bf_lo(v.z); y[8 * q + 5] = bf_hi(v.z); y[8 * q + 6] = bf_lo(v.w); y[8 * q + 7] = bf_hi(v.w); }
#pragma unroll
            for (int e = 0; e < 32; ++e) ss += y[e] * y[e];
            ss += __shfl_xor(ss, 1); ss += __shfl_xor(ss, 2); ss += __shfl_xor(ss, 4);
            const float rs = rsqrtf(ss * (1.f / 256.f) + NORM_EPS);
            const GAS f32x4* gp = (const GAS f32x4*)(gssm + 32 * lane);
            GAS u32x4* op = (GAS u32x4*)(AY + (size_t)m * KAB + 1024 + 32 * lane);
#pragma unroll
            for (int q = 0; q < 4; ++q) { const f32x4 ga = gp[2 * q], gb = gp[2 * q + 1]; u32x4 w;
                w.x = cvt_pk_bf16(y[8 * q + 0] * rs * ga[0], y[8 * q + 1] * rs * ga[1]); w.y = cvt_pk_bf16(y[8 * q + 2] * rs * ga[2], y[8 * q + 3] * rs * ga[3]);
                w.z = cvt_pk_bf16(y[8 * q + 4] * rs * gb[0], y[8 * q + 5] * rs * gb[1]); w.w = cvt_pk_bf16(y[8 * q + 6] * rs * gb[2], y[8 * q + 7] * rs * gb[3]);
                op[q] = w; }
        }
    }
}

template <int KSTEPS> __device__ __forceinline__ f32x4 skinny_acc(const GAS bf16_t* arow, const GAS bf16_t* brow) {
    f32x4 acc = (f32x4){0.f, 0.f, 0.f, 0.f};
#pragma unroll
    for (int k0 = 0; k0 < KSTEPS; k0 += 16) {
        bf16x8 a[16], b[16];
#pragma unroll
        for (int u = 0; u < 16; ++u) { a[u] = *(const GAS bf16x8*)(arow + (k0 + u) * 32); b[u] = *(const GAS bf16x8*)(brow + (k0 + u) * 32); }
        __builtin_amdgcn_sched_barrier(0);
#pragma unroll
        for (int u = 0; u < 16; ++u) acc = MFMA16(a[u], b[u], acc);
        __builtin_amdgcn_sched_barrier(0);
    }
    return acc;
}
__device__ __forceinline__ void decode_merge(GAS unsigned char* wsg, int bid, int G) {
    const GAS bf16_t* AY = (const GAS bf16_t*)(wsg + WS_AY); const GAS bf16_t* WAB = (const GAS bf16_t*)(wsg + WS_WAB); const GAS bf16_t* proj = (const GAS bf16_t*)(wsg + WS_PROJ); GAS bf16_t* MRG = (GAS bf16_t*)(wsg + WS_MRG);
    const int lane = threadIdx.x & 63, wave = threadIdx.x >> 6, fr = lane & 15, g4 = lane >> 4;
    for (int it = bid; it < 256; it += G) {
        const int c0 = (it & 31) * 64 + (wave & 3) * 16, r0 = MP + (it >> 5) * 32 + (wave >> 2) * 16;
        const GAS bf16_t* ar = AY + (size_t)(r0 + fr) * KAB + 8 * g4; const GAS bf16_t* br = WAB + (size_t)(c0 + fr) * KAB + 8 * g4;
        unsigned short gar[4], gbr[4];
#pragma unroll
        for (int r = 0; r < 4; ++r) { const size_t row = (size_t)(r0 + 4 * g4 + r); const int col = c0 + fr; gar[r] = proj[row * NP + C_RA + col]; gbr[r] = proj[row * NP + C_RB + col]; }
        __builtin_amdgcn_sched_barrier(0);
        const f32x4 pa = skinny_acc<32>(ar, br), pb = skinny_acc<64>(ar + 1024, br + 1024);
#pragma unroll
        for (int r = 0; r < 4; ++r) { const size_t row = (size_t)(r0 + 4 * g4 + r); const int col = c0 + fr;
            const float ga = sigmoid_f(bf2f(gar[r])), gb = sigmoid_f(bf2f(gbr[r]));
            MRG[row * DM + col] = f2bf(ga * pa[r] + gb * pb[r]); }
    }
}
__device__ __forceinline__ void decode_out(GAS unsigned char* wsg, int bid, int G) {
    const GAS bf16_t* MRG = (const GAS bf16_t*)(wsg + WS_MRG); const GAS bf16_t* WO = (const GAS bf16_t*)(wsg + WS_WO); GAS float* OUT = (GAS float*)(wsg + WS_OUTD);
    const int lane = threadIdx.x & 63, wave = threadIdx.x >> 6, fr = lane & 15, g4 = lane >> 4;
    for (int it = bid; it < 256; it += G) {
        const int c0 = (it & 31) * 64 + (wave & 3) * 16, r0 = MP + (it >> 5) * 32 + (wave >> 2) * 16;
        const f32x4 acc = skinny_acc<64>(MRG + (size_t)(r0 + fr) * DM + 8 * g4, WO + (size_t)(c0 + fr) * DM + 8 * g4);
#pragma unroll
        for (int r = 0; r < 4; ++r) OUT[(size_t)(r0 - MP + 4 * g4 + r) * DM + c0 + fr] = acc[r];
    }
}

template <bool BF> __device__ __forceinline__ void final_row(const GAS void* orow_, const GAS f32x4* xr, const GAS f32x4* gt4, const GAS f32x4* g4, GAS f32x4* o, int lane) {
    f32x4 v[8], xv[8]; float ss = 0.f;
#pragma unroll
    for (int j = 0; j < 8; ++j) xv[j] = __builtin_nontemporal_load(xr + lane + 64 * j);
    f32x4 ggv[8], gtv[8];
#pragma unroll
    for (int j = 0; j < 8; ++j) { ggv[j] = g4[lane + 64 * j]; gtv[j] = gt4[lane + 64 * j]; }
#pragma unroll
    for (int j = 0; j < 8; ++j) {
        if constexpr (BF) { const u32x2 q = __builtin_nontemporal_load((const GAS u32x2*)orow_ + lane + 64 * j); v[j] = (f32x4){bf_lo(q.x), bf_hi(q.x), bf_lo(q.y), bf_hi(q.y)}; }
        else v[j] = ((const GAS f32x4*)orow_)[lane + 64 * j]; }
    __builtin_amdgcn_sched_barrier(0);
#pragma unroll
    for (int j = 0; j < 8; ++j) {
        ss += (v[j][0] * v[j][0] + v[j][1] * v[j][1]) + (v[j][2] * v[j][2] + v[j][3] * v[j][3]); }
    const float rstd = rsqrtf(wave_sum(ss) * (1.f / DM) + NORM_EPS);
#pragma unroll
    for (int j = 0; j < 8; ++j) { const f32x4 gg = ggv[j], gt = gtv[j], xx = xv[j];
        f32x4 y;
#pragma unroll
        for (int e = 0; e < 4; ++e) y[e] = xx[e] + gt[e] * (v[j][e] * rstd * gg[e]);
        __builtin_nontemporal_store(y, o + lane + 64 * j); }
}
__device__ __forceinline__ void phase7(const Ctx& X, const Args& A) {
    unsigned char* const wsl = fresh_ws(A);
    const GAS float* xp = (const GAS float*)A.in[0]; const GAS float* xs = (const GAS float*)A.in[1]; const GAS f32x4* g4 = (const GAS f32x4*)A.in[12];
    const GAS float* mod = (const GAS float*)(wsl + WS_MOD); const GAS bf16_t* OUT = (const GAS bf16_t*)(wsl + WS_OUT); const GAS float* OUTD = (const GAS float*)(wsl + WS_OUTD);
    const int gw = X.bid * 8 + X.wave, NGW = X.G * 8, lane = X.lane;
    for (int m = gw; m < MP; m += NGW)
        final_row<true>(OUT + (size_t)m * DM, (const GAS f32x4*)(xp + (size_t)m * DM), (const GAS f32x4*)(mod + (m >> 12) * 6144 + 4096), g4, (GAS f32x4*)(A.out + (size_t)m * DM), lane);
    for (int m = gw; m < MD; m += NGW)
        final_row<false>(OUTD + (size_t)m * DM, (const GAS f32x4*)(xs + (size_t)m * DM), (const GAS f32x4*)(mod + (4 + (m >> 3)) * 6144 + 4096), g4, (GAS f32x4*)(A.out + (size_t)(MP + m) * DM), lane);
}

constexpr int NPHASES = 8;
__global__ void __launch_bounds__(512, 2) hyb_fwd(Args args) {
    extern __shared__ __attribute__((aligned(16))) unsigned char lds_raw[];
    Ctx X;
    X.lds = (LAS unsigned char*)lds_raw;
    X.tid = threadIdx.x; X.lane = X.tid & 63; X.wave = __builtin_amdgcn_readfirstlane(X.tid >> 6); X.bid = blockIdx.x; X.G = gridDim.x;
    volatile LAS unsigned* MISC = (volatile LAS unsigned*)(X.lds + MISC_OFF);
    if (X.tid < 64) MISC[X.tid] = 0u;
    __syncthreads();
    unsigned* ctl = (unsigned*)(args.ws + WS_CTL);
    XcdBarrier bar; bar.bar = ctl + CW_BAR; bar.x = 0; bar.st = nullptr;
    if (MK_N_LAUNCHES == 1) bar = xcd_barrier_post(ctl + CW_BAR, MISC + 8);
#define GRID_BAR() do { if (MK_N_LAUNCHES == 1) xcd_barrier(bar); } while (0)
    const int lo = args.ph_lo, hi = args.ph_hi;
#define IN(k) (lo <= (k) && (k) < hi)
#define BOTH(k) (IN(k) && IN((k) + 1))
#define FRESH_WS() unsigned char* ws = fresh_ws(args); (void)ws
#define DO_P0() do { phase0(X, args); if (BOTH(0)) GRID_BAR(); } while (0)
#define DO_P1() do { phase1(X, args); if (BOTH(1)) GRID_BAR(); } while (0)
#define DO_P2() do { FRESH_WS(); \
        pg8::Gemm g{(const GAS bf16_t*)(ws + WS_H), (const GAS bf16_t*)(ws + WS_WIN), MT, NP, DM, DM, DM}; pg8::StaticOrder S; S.init(MT, NP, X.G, X.bid, REP_P2); \
        pg8::EpiProj E{(GAS bf16_t*)(ws + WS_PROJ), NP, (GAS float*)(ws + WS_DT), (GAS bf16_t*)(ws + WS_KVC)}; \
        pg8::SideKvCopy side; side.init((GAS f32x4*)(ws + WS_DUMMY), args.in[2], args.in[3], args.in[4], args.out); \
        pg8::gemm_phase<pg8::EpiProj, pg8::StaticOrder, true, true, pg8::SideKvCopy>(X.lds, g, S, E, side); \
        { constexpr int kShort = (65 * 81) % 256; if (X.G == 256) { if (X.bid >= kShort) late_weight_transposes(X, args, kShort); } else late_weight_transposes(X, args, 0); } \
        if (BOTH(2)) GRID_BAR(); } while (0)
#define DO_P4() do { phase4(X, args); if (BOTH(4)) GRID_BAR(); } while (0)
#define DO_P5() do { FRESH_WS(); \
        pg8::StaticOrder S; S.init(MP, DM, X.G, X.bid, REP_P56); \
        { pg8::Gemm g{(const GAS bf16_t*)(ws + WS_AY), (const GAS bf16_t*)(ws + WS_WAB), MP, DM, 1024, KAB, KAB}; \
          pg8::EpiGateA E{(const GAS bf16_t*)(ws + WS_PROJ) + C_RA, NP, (GAS bf16_t*)(ws + WS_TMP)}; \
          pg8::gemm_phase<pg8::EpiGateA, pg8::StaticOrder, true, true>(X.lds, g, S, E); } \
        { pg8::Gemm g{(const GAS bf16_t*)(ws + WS_AY) + 1024, (const GAS bf16_t*)(ws + WS_WAB) + 1024, MP, DM, 2048, KAB, KAB}; \
          pg8::EpiGateB E{(const GAS bf16_t*)(ws + WS_PROJ) + C_RB, NP, (const GAS bf16_t*)(ws + WS_TMP), (GAS bf16_t*)(ws + WS_MRG)}; \
          pg8::gemm_phase<pg8::EpiGateB, pg8::StaticOrder, true, true>(X.lds, g, S, E); } \
        decode_merge((GAS unsigned char*)ws, X.bid, X.G); \
        if (BOTH(5)) GRID_BAR(); } while (0)
#define DO_P6() do { FRESH_WS(); \
        pg8::Gemm g{(const GAS bf16_t*)(ws + WS_MRG), (const GAS bf16_t*)(ws + WS_WO), MP, DM, DM, DM, DM}; pg8::StaticOrder S; S.init(MP, DM, X.G, X.bid, REP_P56); \
        pg8::EpiOutBf16 E{(GAS bf16_t*)(ws + WS_OUT), DM}; \
        pg8::gemm_phase<pg8::EpiOutBf16, pg8::StaticOrder, true, true>(X.lds, g, S, E); \
        decode_out((GAS unsigned char*)ws, X.bid, X.G); \
        if (BOTH(6)) GRID_BAR(); } while (0)
    if (IN(0)) { DO_P0();
#if REP_P0 > 1
        DO_P0();
#endif
    }
    if (IN(1)) { DO_P1();
#if REP_LIGHT > 1
        DO_P1();
#endif
    }
    if (IN(2)) { DO_P2(); }
    if (IN(3)) { phase3(X, args); GRID_BAR(); phase3b(X, args); if (BOTH(3)) GRID_BAR(); }
    if (IN(4)) { DO_P4();
#if REP_LIGHT > 1
        DO_P4();
#endif
    }
    if (IN(5)) { DO_P5(); }
    if (IN(6)) { DO_P6(); }
    if (IN(7)) { phase7(X, args);
#if REP_LIGHT > 1
        GRID_BAR(); phase7(X, args);
#endif
    }
#undef IN
#undef BOTH
#undef GRID_BAR
}

extern "C" void kernel_launch(void* const* d_in, const int* in_sizes, int n_in, void* d_out, int out_size, void* d_ws, size_t ws_size, hipStream_t stream) {
    static int grid = 0;
    if (grid == 0) {
        if (n_in != 23 || (size_t)out_size != O_END || ws_size < WS_END) { fprintf(stderr, "kernel_launch: unexpected shapes: n_in %d out %d ws %zu\n", n_in, out_size, ws_size); grid = -1; return; }
        int dev = 0, cus = 0, per_cu = 0;
        if (hipGetDevice(&dev) != hipSuccess || hipDeviceGetAttribute(&cus, hipDeviceAttributeMultiprocessorCount, dev) != hipSuccess) { grid = -1; return; }
        if (hipFuncSetAttribute((const void*)hyb_fwd, hipFuncAttributeMaxDynamicSharedMemorySize, LDS_BYTES) != hipSuccess) { fprintf(stderr, "kernel_launch: hipFuncSetAttribute failed\n"); grid = -1; return; }
        if (hipOccupancyMaxActiveBlocksPerMultiprocessor(&per_cu, (const void*)hyb_fwd, 512, LDS_BYTES) != hipSuccess || per_cu < 1) fprintf(stderr, "kernel_launch: occupancy query reports %d\n", per_cu);
        (void)hipGetLastError();
        grid = cus;
    }
    if (grid < 0) return;
    (void)in_sizes;
    if (hipMemsetAsync((char*)d_ws + WS_CTL, 0, CTL_ZERO_BYTES, stream) != hipSuccess) return;
    Args a{};
    for (int i = 0; i < 23; ++i) a.in[i] = d_in[i];
    a.out = (float*)d_out; a.ws = (unsigned char*)d_ws;
    if (MK_N_LAUNCHES == 1) { a.ph_lo = 0; a.ph_hi = NPHASES; hipLaunchKernelGGL(hyb_fwd, dim3(grid), dim3(512), LDS_BYTES, stream, a); }
    else for (int p = 0; p < NPHASES; ++p) { a.ph_lo = p; a.ph_hi = p + 1; hipLaunchKernelGGL(hyb_fwd, dim3(grid), dim3(512), LDS_BYTES, stream, a); }
}
```
